# Optimizing an MI355X kernel written in HIP

```python
import math
import jax
import jax.numpy as jnp
from jax import lax
import numpy as np

D_MODEL = 1024
BATCH = 1
SEQ = 16384
DEPTH = 2

GRID_W = 64
CTX_LEN = 256
GROUP_WIDTH = D_MODEL // 2
MLA_HEADS = 8
MLA_NOPE = 64
MLA_ROPE = 32
MLA_V = GROUP_WIDTH // MLA_HEADS
MLA_Q_RANK = 384
MLA_KV_RANK = 256
S5_CH = 16
S5_GROUPS = GROUP_WIDTH // S5_CH
S5_STATE = 64
DIFF_HEADS = 4
DIFF_QK = 64
DIFF_V = GROUP_WIDTH // DIFF_HEADS
SSD_INNER = GROUP_WIDTH
SSD_HEAD_DIM = 64
SSD_HEADS = SSD_INNER // SSD_HEAD_DIM
SSD_GROUPS = 2
SSD_STATE = 128
SSD_CONV = 5
SSD_CHUNK = 128
D_FF = -(-8 * D_MODEL // (3 * 256)) * 256
Q_BLOCK = 128
ROPE_THETA = 10000.0
EPS = 1e-6
EVEN_SPLIT = (MLA_Q_RANK, MLA_KV_RANK, MLA_ROPE, GROUP_WIDTH)
DIFF_QK_W = DIFF_HEADS * 2 * DIFF_QK
SSD_XBC = SSD_INNER + 2 * SSD_GROUPS * SSD_STATE
ODD_SPLIT = (DIFF_QK_W, DIFF_QK_W, DIFF_HEADS * DIFF_V, SSD_INNER, SSD_XBC, 2 * SSD_HEADS)

kernel_name = 'hybrid_mla_s5_diffattn_ssd_prefix_trunk'


def split_cols(t, sizes):
    return jnp.split(t, np.cumsum(sizes)[:-1].tolist(), axis=-1)


def rms_norm(x, gain=None):
    xf = x.astype(jnp.float32)
    y = (xf * lax.rsqrt(jnp.mean(xf * xf, axis=-1, keepdims=True) + EPS)).astype(x.dtype)
    return y if gain is None else y * gain


def modulate(x, shift, scale):
    return rms_norm(x) * (1.0 + scale) + shift


def swiglu(h, w1, w3, w2):
    return (jax.nn.silu(h @ w1) * (h @ w3)) @ w2


def rope_1d(x, pos):
    n = x.shape[-1] // 2
    inv = ROPE_THETA ** (-jnp.arange(n, dtype=jnp.float32) / n)
    ang = pos.astype(jnp.float32)[:, None] * inv[None, :]
    ang = ang.reshape((1, ang.shape[0]) + (1,) * (x.ndim - 3) + (n,))
    cos = jnp.cos(ang).astype(x.dtype)
    sin = jnp.sin(ang).astype(x.dtype)
    x1, x2 = x[..., :n], x[..., n:]
    return jnp.concatenate([x1 * cos - x2 * sin, x1 * sin + x2 * cos], axis=-1)


def rope_2d(x, pos):
    row, col = pos
    h = x.shape[-1] // 2
    return jnp.concatenate([rope_1d(x[..., :h], row), rope_1d(x[..., h:], col)], axis=-1)


def dense_attention(q, k, v, map_w):
    bsz, lq, nh, nm, dk = q.shape
    dv = v.shape[-1]
    scale = dk ** -0.5

    def one_block(qb):
        s = jnp.einsum('bqhmd,bkhmd->bhmqk', qb, k).astype(jnp.float32) * scale
        p = jnp.einsum('bhmqk,m->bhqk', jax.nn.softmax(s, axis=-1), map_w.astype(jnp.float32))
        return jnp.einsum('bhqk,bkhd->bqhd', p.astype(v.dtype), v)

    nb = lq // Q_BLOCK
    qb = q.reshape(bsz, nb, Q_BLOCK, nh, nm, dk).transpose(1, 0, 2, 3, 4, 5)
    out = lax.map(one_block, qb)
    return out.transpose(1, 0, 2, 3, 4).reshape(bsz, lq, nh, dv)


def mla_queries(cq, g_qa, w_qb, g_qn, pos):
    bsz, seq, _ = cq.shape
    q = (rms_norm(cq, g_qa) @ w_qb).reshape(bsz, seq, MLA_HEADS, MLA_NOPE + MLA_ROPE)
    q = rms_norm(q, g_qn)
    if pos is not None:
        q = jnp.concatenate([q[..., :MLA_NOPE], rope_2d(q[..., MLA_NOPE:], pos)], axis=-1)
    return q[:, :, :, None, :]


def mla_keys_values(ckv, kr, g_kva, w_kvb, g_kn, pos):
    bsz, seq, _ = ckv.shape
    kv = (rms_norm(ckv, g_kva) @ w_kvb).reshape(bsz, seq, MLA_HEADS, MLA_NOPE + MLA_V)
    k_nope, v = kv[..., :MLA_NOPE], kv[..., MLA_NOPE:]
    k_rope = jnp.broadcast_to(kr[:, :, None, :], (bsz, seq, MLA_HEADS, MLA_ROPE))
    k = rms_norm(jnp.concatenate([k_nope, k_rope], axis=-1), g_kn)
    if pos is not None:
        k = jnp.concatenate([k[..., :MLA_NOPE], rope_2d(k[..., MLA_NOPE:], pos)], axis=-1)
    return k[:, :, :, None, :], v


def _complex_affine_combine(e1, e2):
    a1r, a1i, b1r, b1i = e1
    a2r, a2i, b2r, b2i = e2
    return (a2r * a1r - a2i * a1i,
            a2r * a1i + a2i * a1r,
            a2r * b1r - a2i * b1i + b2r,
            a2r * b1i + a2i * b1r + b2i)


def s5_scan(u, lam_re, lam_im, log_dt, b_re, b_im, c_re, c_im, h0, reverse, need_y):
    dt = jnp.exp(log_dt)[:, None]
    mag = jnp.exp(lam_re * dt)
    ang = lam_im * dt
    a_re = mag * jnp.cos(ang)
    a_im = mag * jnp.sin(ang)
    den = lam_re * lam_re + lam_im * lam_im
    k_re = ((a_re - 1.0) * lam_re + a_im * lam_im) / den
    k_im = (a_im * lam_re - (a_re - 1.0) * lam_im) / den
    bb_re = k_re[..., None] * b_re - k_im[..., None] * b_im
    bb_im = k_re[..., None] * b_im + k_im[..., None] * b_re
    bu_re = jnp.einsum('blgc,gnc->blgn', u, bb_re)
    bu_im = jnp.einsum('blgc,gnc->blgn', u, bb_im)
    a_re = jnp.broadcast_to(a_re, bu_re.shape)
    a_im = jnp.broadcast_to(a_im, bu_re.shape)
    p_re, p_im, h_re, h_im = lax.associative_scan(
        _complex_affine_combine, (a_re, a_im, bu_re, bu_im), reverse=reverse, axis=1)
    if h0 is not None:
        h0_re, h0_im = h0[0][:, None], h0[1][:, None]
        h_re, h_im = h_re + p_re * h0_re - p_im * h0_im, h_im + p_re * h0_im + p_im * h0_re
    end = 0 if reverse else -1
    final = (h_re[:, end], h_im[:, end])
    if not need_y:
        return None, final
    y = jnp.einsum('blgn,gcn->blgc', h_re, c_re) - jnp.einsum('blgn,gcn->blgc', h_im, c_im)
    return y, final


def s5_glu(y, w_glu, b_glu):
    g = jax.nn.gelu(y)
    return g * jax.nn.sigmoid(g @ w_glu + b_glu)


def s5_mixer(u, u_c, need_ctx, lam_re, lam_im, log_dt, b_re, b_im, c_re, c_im, d_skip, w_glu, b_glu):
    bsz, seq, _ = u.shape
    seq_c = u_c.shape[1]
    ug = u.reshape(bsz, seq, S5_GROUPS, S5_CH)
    ug_c = u_c.reshape(bsz, seq_c, S5_GROUPS, S5_CH)
    y = ug * d_skip
    y_c = ug_c * d_skip
    for di in range(2):
        rev = di == 1
        yd_c, h_c = s5_scan(ug_c, lam_re[di], lam_im[di], log_dt[di], b_re[di], b_im[di],
                            c_re[di], c_im[di], None, rev, need_ctx)
        yd, _ = s5_scan(ug, lam_re[di], lam_im[di], log_dt[di], b_re[di], b_im[di],
                        c_re[di], c_im[di], h_c, rev, True)
        y = y + yd
        if need_ctx:
            y_c = y_c + yd_c
    out = s5_glu(y.reshape(bsz, seq, GROUP_WIDTH), w_glu, b_glu)
    out_c = s5_glu(y_c.reshape(bsz, seq_c, GROUP_WIDTH), w_glu, b_glu) if need_ctx else None
    return out, out_c


def even_mixer(h, h_c, pos, need_ctx, w_in, w_out, g_qa, w_qb, g_kva, w_kvb, g_qn, g_kn,
               lam_re, lam_im, log_dt, b_re, b_im, c_re, c_im, d_skip, w_glu, b_glu):
    bsz, seq, _ = h.shape
    seq_c = h_c.shape[1]
    cq, ckv, kr, u = split_cols(h @ w_in, EVEN_SPLIT)
    cq_c, ckv_c, kr_c, u_c = split_cols(h_c @ w_in, EVEN_SPLIT)
    one_map = jnp.ones((1,), jnp.float32)
    q = mla_queries(cq, g_qa, w_qb, g_qn, pos)
    k, v = mla_keys_values(ckv, kr, g_kva, w_kvb, g_kn, pos)
    k_c, v_c = mla_keys_values(ckv_c, kr_c, g_kva, w_kvb, g_kn, None)
    att = dense_attention(q, jnp.concatenate([k_c, k], axis=1), jnp.concatenate([v_c, v], axis=1), one_map)
    ssm, ssm_c = s5_mixer(u, u_c, need_ctx, lam_re, lam_im, log_dt, b_re, b_im, c_re, c_im,
                          d_skip, w_glu, b_glu)
    y = jnp.concatenate([att.reshape(bsz, seq, GROUP_WIDTH), ssm], axis=-1) @ w_out
    if not need_ctx:
        return y, None
    att_c = dense_attention(mla_queries(cq_c, g_qa, w_qb, g_qn, None), k_c, v_c, one_map)
    y_c = jnp.concatenate([att_c.reshape(bsz, seq_c, GROUP_WIDTH), ssm_c], axis=-1) @ w_out
    return y, y_c


def segsum(x):
    t = x.shape[-1]
    idx = jnp.arange(t)
    xx = jnp.where(idx[:, None] > idx[None, :], x[..., :, None], 0.0)
    ss = jnp.cumsum(xx, axis=-2)
    return jnp.where(idx[:, None] >= idx[None, :], ss, -jnp.inf)


def ssd_chunked(x, dt, a, bm, cm, h0, need_y):
    bsz, seq, nh, hp = x.shape
    ns = bm.shape[-1]
    nc = seq // SSD_CHUNK
    x = x.reshape(bsz, nc, SSD_CHUNK, nh, hp)
    dt = dt.reshape(bsz, nc, SSD_CHUNK, nh)
    bm = bm.reshape(bsz, nc, SSD_CHUNK, nh, ns)
    cm = cm.reshape(bsz, nc, SSD_CHUNK, nh, ns)
    da = jnp.moveaxis(dt * a, -1, 1)
    a_cs = jnp.cumsum(da, axis=-1)
    xdt = x * dt[..., None]
    decay_states = jnp.exp(a_cs[..., -1:] - a_cs)
    states = jnp.einsum('bcshn,bhcs,bcshp->bchpn', bm, decay_states, xdt)
    states = jnp.concatenate([h0[:, None].astype(states.dtype), states], axis=1)
    chunk_decay = jnp.exp(segsum(jnp.pad(a_cs[..., -1], ((0, 0), (0, 0), (1, 0)))))
    states = jnp.einsum('bhzc,bchpn->bzhpn', chunk_decay, states)
    final = states[:, -1]
    if not need_y:
        return None, final
    y_diag = jnp.einsum('bclhn,bcshn,bhcls,bcshp->bclhp', cm, bm, jnp.exp(segsum(da)), xdt)
    y_off = jnp.einsum('bclhn,bchpn,bhcl->bclhp', cm, states[:, :-1], jnp.exp(a_cs))
    return (y_diag + y_off).reshape(bsz, seq, nh, hp), final


def short_conv(t, w, b):
    pad = w.shape[0] // 2
    out = lax.conv_general_dilated(t, w[:, None, :].astype(t.dtype), window_strides=(1,),
                                   padding=[(pad, pad)], dimension_numbers=('NWC', 'WIO', 'NWC'),
                                   feature_group_count=t.shape[-1])
    return out + b


def ssd_streams(xbc, conv_w, conv_b):
    bsz, seq, _ = xbc.shape
    xbc = jax.nn.silu(short_conv(xbc, conv_w, conv_b))
    x, bm, cm = split_cols(xbc, (SSD_INNER, SSD_GROUPS * SSD_STATE, SSD_GROUPS * SSD_STATE))
    rep = SSD_HEADS // SSD_GROUPS
    bm = jnp.repeat(bm.reshape(bsz, seq, SSD_GROUPS, SSD_STATE), rep, axis=2)
    cm = jnp.repeat(cm.reshape(bsz, seq, SSD_GROUPS, SSD_STATE), rep, axis=2)
    return x.reshape(bsz, seq, SSD_HEADS, SSD_HEAD_DIM), bm, cm


def _flip(t, rev):
    return t[:, ::-1] if rev else t


def ssd_gated_norm(y, z, g):
    bsz, seq = y.shape[:2]
    gy = (y.reshape(bsz, seq, SSD_INNER) * jax.nn.silu(z)).reshape(bsz, seq, SSD_GROUPS, SSD_INNER // SSD_GROUPS)
    return rms_norm(gy).reshape(bsz, seq, SSD_INNER) * g


def ssd_mixer(z, xbc, dtr, z_c, xbc_c, dtr_c, need_ctx, conv_w, conv_b, dt_bias, a_log, d_skip, g_norm):
    x, bm, cm = ssd_streams(xbc, conv_w, conv_b)
    x_c, bm_c, cm_c = ssd_streams(xbc_c, conv_w, conv_b)
    y = x * d_skip[:, None]
    y_c = x_c * d_skip[:, None]
    h0 = jnp.zeros((x_c.shape[0], SSD_HEADS, SSD_HEAD_DIM, SSD_STATE), x.dtype)
    for di in range(2):
        rev = di == 1
        a = -jnp.exp(a_log[di])
        hs = slice(di * SSD_HEADS, (di + 1) * SSD_HEADS)
        dt = jax.nn.softplus(dtr[..., hs] + dt_bias[di])
        dt_c = jax.nn.softplus(dtr_c[..., hs] + dt_bias[di])
        yd_c, h_c = ssd_chunked(_flip(x_c, rev), _flip(dt_c, rev), a, _flip(bm_c, rev), _flip(cm_c, rev),
                                h0, need_ctx)
        yd, _ = ssd_chunked(_flip(x, rev), _flip(dt, rev), a, _flip(bm, rev), _flip(cm, rev), h_c, True)
        y = y + _flip(yd, rev)
        if need_ctx:
            y_c = y_c + _flip(yd_c, rev)
    out = ssd_gated_norm(y, z, g_norm)
    out_c = ssd_gated_norm(y_c, z_c, g_norm) if need_ctx else None
    return out, out_c


def diff_qk(t, g, pos):
    t = rms_norm(t.reshape(t.shape[0], t.shape[1], DIFF_HEADS, 2, DIFF_QK), g)
    return t if pos is None else rope_2d(t, pos)


def diff_values(t):
    return t.reshape(t.shape[0], t.shape[1], DIFF_HEADS, DIFF_V)


def diff_heads_out(o, g_o, lam_init):
    return (rms_norm(o, g_o) * (1.0 - lam_init)).reshape(o.shape[0], o.shape[1], GROUP_WIDTH)


def odd_mixer(h, h_c, pos, need_ctx, layer_idx, w_in, w_out, g_q, g_k, lq1, lk1, lq2, lk2, g_o,
              conv_w, conv_b, dt_bias, a_log, d_skip, g_ssd):
    q, k, v, z, xbc, dtr = split_cols(h @ w_in, ODD_SPLIT)
    q_c, k_c, v_c, z_c, xbc_c, dtr_c = split_cols(h_c @ w_in, ODD_SPLIT)
    lam_init = 0.8 - 0.6 * math.exp(-0.3 * layer_idx)
    lam = (jnp.exp(jnp.sum(lq1 * lk1).astype(jnp.float32))
           - jnp.exp(jnp.sum(lq2 * lk2).astype(jnp.float32)) + lam_init)
    map_w = jnp.stack([jnp.ones_like(lam), -lam])
    kk_c = diff_qk(k_c, g_k, None)
    vv_c = diff_values(v_c)
    att = dense_attention(diff_qk(q, g_q, pos),
                          jnp.concatenate([kk_c, diff_qk(k, g_k, pos)], axis=1),
                          jnp.concatenate([vv_c, diff_values(v)], axis=1), map_w)
    att = diff_heads_out(att, g_o, lam_init)
    ssm, ssm_c = ssd_mixer(z, xbc, dtr, z_c, xbc_c, dtr_c, need_ctx, conv_w, conv_b, dt_bias, a_log,
                           d_skip, g_ssd)
    y = jnp.concatenate([att, ssm], axis=-1) @ w_out
    if not need_ctx:
        return y, None
    att_c = diff_heads_out(dense_attention(diff_qk(q_c, g_q, None), kk_c, vv_c, map_w), g_o, lam_init)
    return y, jnp.concatenate([att_c, ssm_c], axis=-1) @ w_out


def setup_inputs(seed: int = 0) -> dict:
    key = jax.random.key(seed)
    keys = iter(jax.random.split(key, 64))
    f32 = jnp.float32
    d = D_MODEL
    ne = (DEPTH + 1) // 2
    no = DEPTH // 2
    mix = 2 * GROUP_WIDTH

    def normal(shape, scale):
        return jax.random.normal(next(keys), shape, f32) * scale

    def gain(shape):
        return 1.0 + normal(shape, 0.02)

    def log_uniform(shape, lo, hi):
        return jax.random.uniform(next(keys), shape, f32, math.log(lo), math.log(hi))

    dt_ssd = jnp.exp(log_uniform((no, 2, SSD_HEADS), 1e-3, 1e-1))
    s5_shape = (ne, 2, S5_GROUPS, S5_STATE)
    return {
        'x': normal((BATCH, SEQ, d), 1.0),
        'c': normal((BATCH, d), 1.0),
        'ctx': normal((BATCH, CTX_LEN, d), 1.0),
        'c_ctx': normal((d,), 1.0),
        'ada_w': normal((DEPTH, d, 6 * d), 0.5 * d ** -0.5),
        'ada_b': normal((DEPTH, 6 * d), 0.02),
        'ffn_w1': normal((DEPTH, d, D_FF), d ** -0.5),
        'ffn_w3': normal((DEPTH, d, D_FF), d ** -0.5),
        'ffn_w2': normal((DEPTH, D_FF, d), D_FF ** -0.5),
        'e_w_in': normal((ne, d, sum(EVEN_SPLIT)), d ** -0.5),
        'e_w_out': normal((ne, mix, d), mix ** -0.5),
        'mla_g_qa': gain((ne, MLA_Q_RANK)),
        'mla_w_qb': normal((ne, MLA_Q_RANK, MLA_HEADS * (MLA_NOPE + MLA_ROPE)), MLA_Q_RANK ** -0.5),
        'mla_g_kva': gain((ne, MLA_KV_RANK)),
        'mla_w_kvb': normal((ne, MLA_KV_RANK, MLA_HEADS * (MLA_NOPE + MLA_V)), MLA_KV_RANK ** -0.5),
        'mla_g_qn': gain((ne, MLA_NOPE + MLA_ROPE)),
        'mla_g_kn': gain((ne, MLA_NOPE + MLA_ROPE)),
        's5_lam_re': -0.5 + normal(s5_shape, 0.01),
        's5_lam_im': math.pi * jnp.arange(S5_STATE, dtype=f32) + normal(s5_shape, 0.01),
        's5_log_dt': log_uniform((ne, 2, S5_GROUPS), 1e-3, 1e-1),
        's5_b_re': normal((ne, 2, S5_GROUPS, S5_STATE, S5_CH), (2 * S5_CH) ** -0.5),
        's5_b_im': normal((ne, 2, S5_GROUPS, S5_STATE, S5_CH), (2 * S5_CH) ** -0.5),
        's5_c_re': normal((ne, 2, S5_GROUPS, S5_CH, S5_STATE), S5_STATE ** -0.5),
        's5_c_im': normal((ne, 2, S5_GROUPS, S5_CH, S5_STATE), S5_STATE ** -0.5),
        's5_d': normal((ne, S5_GROUPS, S5_CH), 1.0),
        's5_w_glu': normal((ne, GROUP_WIDTH, GROUP_WIDTH), GROUP_WIDTH ** -0.5),
        's5_b_glu': normal((ne, GROUP_WIDTH), 0.02),
        'o_w_in': normal((no, d, sum(ODD_SPLIT)), d ** -0.5),
        'o_w_out': normal((no, mix, d), mix ** -0.5),
        'diff_g_q': gain((no, DIFF_QK)),
        'diff_g_k': gain((no, DIFF_QK)),
        'diff_lq1': normal((no, DIFF_QK), 0.1),
        'diff_lk1': normal((no, DIFF_QK), 0.1),
        'diff_lq2': normal((no, DIFF_QK), 0.1),
        'diff_lk2': normal((no, DIFF_QK), 0.1),
        'diff_g_o': gain((no, DIFF_V)),
        'ssd_conv_w': normal((no, SSD_CONV, SSD_XBC), SSD_CONV ** -0.5),
        'ssd_conv_b': normal((no, SSD_XBC), 0.02),
        'ssd_dt_bias': dt_ssd + jnp.log(-jnp.expm1(-dt_ssd)),
        'ssd_a_log': jnp.log(jax.random.uniform(next(keys), (no, 2, SSD_HEADS), f32, 1.0, 16.0)),
        'ssd_d': gain((no, SSD_HEADS)),
        'ssd_g': gain((no, SSD_INNER)),
    }


def reference(x, c, ctx, c_ctx, ada_w, ada_b, ffn_w1, ffn_w3, ffn_w2, e_w_in, e_w_out,
              mla_g_qa, mla_w_qb, mla_g_kva, mla_w_kvb, mla_g_qn, mla_g_kn,
              s5_lam_re, s5_lam_im, s5_log_dt, s5_b_re, s5_b_im, s5_c_re, s5_c_im, s5_d,
              s5_w_glu, s5_b_glu, o_w_in, o_w_out, diff_g_q, diff_g_k, diff_lq1, diff_lk1,
              diff_lq2, diff_lk2, diff_g_o, ssd_conv_w, ssd_conv_b, ssd_dt_bias, ssd_a_log,
              ssd_d, ssd_g):
    seq = x.shape[1]
    rows = seq // GRID_W
    pos = (jnp.repeat(jnp.arange(rows), GRID_W), jnp.tile(jnp.arange(GRID_W), rows))
    silu_c = jax.nn.silu(c)
    silu_cc = jax.nn.silu(c_ctx)
    for i in range(DEPTH):
        need_ctx = i < DEPTH - 1
        j = i // 2
        mod = (silu_c @ ada_w[i] + ada_b[i])[:, None, :]
        mod_c = silu_cc @ ada_w[i] + ada_b[i]
        sh_a, sc_a, g_a, sh_f, sc_f, g_f = jnp.split(mod, 6, axis=-1)
        shc_a, scc_a, gc_a, shc_f, scc_f, gc_f = jnp.split(mod_c, 6, axis=-1)
        h = modulate(x, sh_a, sc_a)
        h_c = modulate(ctx, shc_a, scc_a)
        if i % 2 == 0:
            y, y_c = even_mixer(h, h_c, pos, need_ctx, e_w_in[j], e_w_out[j], mla_g_qa[j], mla_w_qb[j],
                                mla_g_kva[j], mla_w_kvb[j], mla_g_qn[j], mla_g_kn[j], s5_lam_re[j],
                                s5_lam_im[j], s5_log_dt[j], s5_b_re[j], s5_b_im[j], s5_c_re[j], s5_c_im[j],
                                s5_d[j], s5_w_glu[j], s5_b_glu[j])
        else:
            y, y_c = odd_mixer(h, h_c, pos, need_ctx, i, o_w_in[j], o_w_out[j], diff_g_q[j], diff_g_k[j],
                               diff_lq1[j], diff_lk1[j], diff_lq2[j], diff_lk2[j], diff_g_o[j],
                               ssd_conv_w[j], ssd_conv_b[j], ssd_dt_bias[j], ssd_a_log[j], ssd_d[j], ssd_g[j])
        x = x + g_a * y
        x = x + g_f * swiglu(modulate(x, sh_f, sc_f), ffn_w1[i], ffn_w3[i], ffn_w2[i])
        if need_ctx:
            ctx = ctx + gc_a * y_c
            ctx = ctx + gc_f * swiglu(modulate(ctx, shc_f, scc_f), ffn_w1[i], ffn_w3[i], ffn_w2[i])
    return x
```

```cpp
#include <hip/hip_runtime.h>
#include <hip/hip_cooperative_groups.h>
#include <cstdio>
#include <cstdint>
namespace cg = cooperative_groups;

#ifndef N_LAUNCH_MODE
#define N_LAUNCH_MODE 0
#endif

typedef unsigned short bf16_t;
typedef short bf16x8 __attribute__((ext_vector_type(8)));
typedef short s16x4 __attribute__((ext_vector_type(4)));
typedef float f32x16 __attribute__((ext_vector_type(16)));
typedef float f32x4 __attribute__((ext_vector_type(4)));
typedef unsigned u32x4 __attribute__((ext_vector_type(4)));
typedef unsigned u32x2 __attribute__((ext_vector_type(2)));
#define DI __device__ __forceinline__
#define MFMA32(a, b, c) __builtin_amdgcn_mfma_f32_32x32x16_bf16((a), (b), (c), 0, 0, 0)

constexpr int L = 16384, NC = 256, T = L + NC, DM = 1024, DFF = 2816;
constexpr int NTHREADS = 512, NWAVES = 8;
constexpr float EPS = 1e-6f;
constexpr float LOG2E = 1.4426950408889634f;
constexpr float LAM_INIT = 0.35550906759f;
constexpr int S5T = 32, S5M = T / S5T  , S5K = 16 * S5T + 256  , S5N = 16 * S5T  , S5MP = 768  ;
constexpr int SQ = 128, SNC = T / SQ  ;

constexpr size_t al256(size_t x) { return (x + 255) / 256 * 256; }
constexpr size_t UB = (size_t)T * 1024;
constexpr size_t W_IN0 = 0;
constexpr size_t W_QB = W_IN0 + (size_t)1280 * 1024 * 2;
constexpr size_t W_KVB = W_QB + (size_t)768 * 384 * 2;
constexpr size_t W_GLU = W_KVB + (size_t)1024 * 256 * 2;
constexpr size_t W_OUT0 = W_GLU + (size_t)512 * 512 * 2;
constexpr size_t W_13_0 = W_OUT0 + (size_t)1024 * 1024 * 2;
constexpr size_t W_2_0 = W_13_0 + (size_t)5632 * 1024 * 2;
constexpr size_t W_IN1 = W_2_0 + (size_t)1024 * 2816 * 2;
constexpr size_t W_OUT1 = W_IN1 + (size_t)3328 * 1024 * 2;
constexpr size_t W_13_1 = W_OUT1 + (size_t)1024 * 1024 * 2;
constexpr size_t W_2_1 = W_13_1 + (size_t)5632 * 1024 * 2;
constexpr size_t W_END = W_2_1 + (size_t)1024 * 2816 * 2;
constexpr size_t M_MODS = al256(W_END);
constexpr size_t M_APOW = M_MODS + 4 * 6144 * 4;
constexpr size_t M_BB = M_APOW + (size_t)2 * 32 * 33 * 64 * 2 * 4;
constexpr size_t M_KT = M_BB + (size_t)2 * 32 * 64 * 16 * 2 * 4;
constexpr size_t M_ROPE16 = M_KT + (size_t)2 * 32 * 32 * 256 * 4;
constexpr size_t M_ROPE8 = M_ROPE16 + 256 * 16 * 2 * 4;
constexpr size_t M_CONST = M_ROPE8 + 256 * 8 * 2 * 4;
constexpr size_t M_XC = M_CONST + 256;
constexpr size_t M_DTR = M_XC + (size_t)NC * 1024 * 4;
constexpr size_t M_CS = M_DTR + (size_t)T * 16 * 4;
constexpr size_t M_DEC = M_CS + (size_t)T * 16 * 4;
constexpr size_t M_BAR = al256(M_DEC + 2 * SNC * 8 * 4);
constexpr size_t M_END = M_BAR + 3456 * 4;
constexpr size_t DYN0 = al256(M_END);
constexpr size_t R_A = DYN0;
constexpr size_t R_B = R_A + 2 * UB;
constexpr size_t R_C = R_B + (size_t)T * 672 * 2;
constexpr size_t R_D = R_C + (size_t)32 * S5MP * S5K * 2;
constexpr size_t R_D2 = R_D + (size_t)32 * S5N * S5K * 2;
constexpr size_t R_E = R_D2 + (size_t)32 * 256 * 512 * 2;
constexpr size_t R_F = R_E + (size_t)32 * S5M * 256 * 4;
constexpr size_t R_G = R_F + UB;
constexpr size_t R_END0 = R_G + (size_t)T * 768 * 2;
constexpr size_t R_H = R_A;
constexpr size_t R_HFF = R_B;
constexpr size_t R1_QK = R_B;
constexpr size_t R1_V = R1_QK + 2 * UB;
constexpr size_t R1_Z = R1_V + UB;
constexpr size_t R1_XBC = R1_Z + UB;
constexpr size_t R1_SS = R1_XBC + 2 * UB;
constexpr size_t R1_YP = R1_SS + (size_t)2 * SNC * 8 * 64 * 128 * 2;
constexpr size_t R1_CC = R1_YP + UB;
constexpr size_t R1_END = R1_CC + (size_t)T * 256 * 2;
constexpr size_t WS_NEED = (R_END0 > R1_END ? R_END0 : R1_END);
static_assert(R_HFF + (size_t)T * 2816 * 2 <= (size_t)256 * 1024 * 1024, "HFF fits");
static_assert(WS_NEED <= (size_t)256 * 1024 * 1024, "workspace fits in 256 MiB");
constexpr size_t O_Q0 = 0;
constexpr size_t O_KN = O_Q0 + (size_t)T * 768 * 2;
constexpr size_t O_GG = O_KN + UB;
static_assert(O_GG + UB <= (size_t)L * 1024 * 4, "d_out scratch fits");

constexpr int LDS_BYTES = 144 * 1024;

struct KP {
    const float* in[42];
    float* out;
    unsigned char* ws;
    int ph_lo, ph_hi;
};

typedef float f32x2_t __attribute__((ext_vector_type(2)));
typedef __bf16 bf16x2_t __attribute__((ext_vector_type(2)));
DI unsigned cvtpk(float lo, float hi) { const f32x2_t v = {lo, hi}; const bf16x2_t r = __builtin_convertvector(v, bf16x2_t); return __builtin_bit_cast(unsigned, r); }
DI bf16_t f2bf(float x) { const __bf16 b = (__bf16)x; return __builtin_bit_cast(unsigned short, b); }
DI float bf2f(bf16_t b) { return __uint_as_float((unsigned)b << 16); }
DI float bflo(unsigned w) { return __uint_as_float(w << 16); }
DI float bfhi(unsigned w) { return __uint_as_float(w & 0xffff0000u); }
DI int crow(int r, int hi) { return (r & 3) + 8 * (r >> 2) + 4 * hi; }
DI int tid_l() { int t = threadIdx.x; asm volatile("" : "+v"(t)); return t; }
DI float wave_sum(float v) {
#pragma unroll
    for (int o = 1; o < 64; o <<= 1) v += __shfl_xor(v, o);
    return v;
}
DI float silu_f(float x) { return x / (1.f + __expf(-x)); }
DI float sigmoid_f(float x) { return 1.f / (1.f + __expf(-x)); }
DI float gelu_tanh(float x) { const float u = 0.7978845608028654f * (x + 0.044715f * x * x * x); const float t = 1.f - 2.f / (1.f + __expf(2.f * u)); return 0.5f * x * (1.f + t); }
DI float softplus_f(float x) { return fmaxf(x, 0.f) + log1pf(__expf(-fabsf(x))); }

struct GP { const bf16_t* A; const bf16_t* Bt; long aBatch, bBatch; int lda, ldb, K, Mtot, mt, nt, nb, epi; };
enum { EPI_G1 = 0, EPI_QRAW, EPI_KV, EPI_S5S, EPI_S5Y, EPI_GLU, EPI_RES_A0, EPI_SWIGLU, EPI_RES_F0, EPI_G8, EPI_RES_A1, EPI_RES_F1, EPI_CTX_A0, EPI_CTX_F0 };

template <int EPI> DI void epi_put(const KP& P, int b, int row, int col, float v) {
    unsigned char* ws = P.ws;
    if constexpr (EPI == EPI_G1) {
        if (col < 672) ((bf16_t*)(ws + R_B))[(size_t)row * 672 + col] = f2bf(v);
        else if (col < 1184) { const int cc = col - 672, g = cc >> 4, c = cc & 15, m = row >> 5, s = row & 31;
            ((bf16_t*)(ws + R_C))[((size_t)g * S5MP + m) * S5K + s * 16 + c] = f2bf(v); }
    } else if constexpr (EPI == EPI_QRAW) { ((bf16_t*)((unsigned char*)P.out + O_Q0))[(size_t)row * 768 + col] = f2bf(v);
    } else if constexpr (EPI == EPI_KV) { const int h = col >> 7, w = col & 127;
        if (w < 64) ((bf16_t*)((unsigned char*)P.out + O_KN))[(size_t)row * 512 + h * 64 + w] = f2bf(v);
        else ((bf16_t*)(ws + R_F))[(size_t)row * 512 + h * 64 + (w - 64)] = f2bf(v);
    } else if constexpr (EPI == EPI_S5S) { ((float*)(ws + R_E))[((size_t)b * S5M + row) * 256 + col] = v;
    } else if constexpr (EPI == EPI_S5Y) { const int t = col >> 4, ch = col & 15; const size_t trow = (size_t)row * 32 + t;
        ((bf16_t*)((unsigned char*)P.out + O_GG))[trow * 512 + b * 16 + ch] = f2bf(gelu_tanh(v));
    } else if constexpr (EPI == EPI_GLU) { const float g = bf2f(((const bf16_t*)((unsigned char*)P.out + O_GG))[(size_t)row * 512 + col]);
        ((bf16_t*)(ws + R_H))[(size_t)row * 1024 + 512 + col] = f2bf(g * sigmoid_f(v + P.in[26][col]));
    } else if constexpr (EPI == EPI_RES_A0) { const float* mods = (const float*)(ws + M_MODS);
        if (row < L) P.out[(size_t)row * 1024 + col] = P.in[0][(size_t)row * 1024 + col] + mods[0 * 6144 + 2048 + col] * v;
        else ((float*)(ws + M_XC))[(size_t)(row - L) * 1024 + col] = P.in[2][(size_t)(row - L) * 1024 + col] + mods[1 * 6144 + 2048 + col] * v;
    } else if constexpr (EPI == EPI_RES_F0) { const float* mods = (const float*)(ws + M_MODS);
        if (row < L) P.out[(size_t)row * 1024 + col] += mods[0 * 6144 + 5120 + col] * v;
        else ((float*)(ws + M_XC))[(size_t)(row - L) * 1024 + col] += mods[1 * 6144 + 5120 + col] * v;
    } else if constexpr (EPI == EPI_G8) {
        if (col < 1024) ((bf16_t*)(ws + R1_QK))[(size_t)row * 1024 + col] = f2bf(v);
        else if (col < 1536) ((bf16_t*)(ws + R1_V))[(size_t)row * 512 + col - 1024] = f2bf(v);
        else if (col < 2048) ((bf16_t*)(ws + R1_Z))[(size_t)row * 512 + col - 1536] = f2bf(v);
        else if (col < 3072) ((bf16_t*)(ws + R1_XBC))[(size_t)row * 1024 + col - 2048] = f2bf(v);
        else if (col < 3088) ((float*)(ws + M_DTR))[(size_t)row * 16 + col - 3072] = v;
    } else if constexpr (EPI == EPI_RES_A1) { const float* mods = (const float*)(ws + M_MODS);
        P.out[(size_t)row * 1024 + col] += mods[2 * 6144 + 2048 + col] * v;
    } else if constexpr (EPI == EPI_RES_F1) { const float* mods = (const float*)(ws + M_MODS);
        P.out[(size_t)row * 1024 + col] += mods[2 * 6144 + 5120 + col] * v;
    } else if constexpr (EPI == EPI_CTX_A0) { const float* mods = (const float*)(ws + M_MODS);
        atomicAdd((float*)(ws + M_XC) + (size_t)row * 1024 + col, mods[1 * 6144 + 2048 + col] * v);
    } else if constexpr (EPI == EPI_CTX_F0) { const float* mods = (const float*)(ws + M_MODS);
        atomicAdd((float*)(ws + M_XC) + (size_t)row * 1024 + col, mods[1 * 6144 + 5120 + col] * v);
    }
}
template <int EPI> DI void epi_all(const KP& P, const f32x16 (&acc)[4][2], int b, int m0, int n0, int Mtot, int wr, int wc, int r32, int hi) {
    const int col = n0 + wc * 32 + r32;
#pragma unroll
    for (int i = 0; i < 4; ++i)
#pragma unroll
        for (int r = 0; r < 16; ++r) {
            const int row = m0 + wr * 128 + i * 32 + crow(r, hi);
            bool ok = true;
            if constexpr (EPI == EPI_S5S || EPI == EPI_S5Y) ok = row < Mtot;
            if (ok) {
                if constexpr (EPI == EPI_SWIGLU) ((bf16_t*)(P.ws + R_HFF))[(size_t)row * DFF + (n0 >> 1) + (col - n0)] = f2bf(silu_f(acc[i][0][r]) * acc[i][1][r]);
                else { epi_put<EPI>(P, b, row, col, acc[i][0][r]); epi_put<EPI>(P, b, row, col + 128, acc[i][1][r]); }
            }
            if ((r & 3) == 3) __builtin_amdgcn_sched_barrier(0);
        }
}

template <int EPI> DI void gemm_unit(const KP& P, const GP& g, int b, int pm, int pn, unsigned char* lds) {
    const int tid = tid_l(), lane = tid & 63, wid = tid >> 6, wr = wid >> 2, wc = wid & 3, r32 = lane & 31, hi = lane >> 5;
    const int m0 = pm * 256, n0 = pn * 256, K = g.K, nk = K / 64;
    const bf16_t* A = g.A + (size_t)b * g.aBatch; const bf16_t* Bt = g.Bt + (size_t)b * g.bBatch;
    const int sc = tid & 7, sr = tid >> 3;
    int aoff[4], boff[4];
#pragma unroll
    for (int i = 0; i < 4; ++i) { int ar = m0 + sr + 64 * i; ar = ar < g.Mtot ? ar : g.Mtot - 1; aoff[i] = ar * g.lda + sc * 8; boff[i] = (n0 + sr + 64 * i) * g.ldb + sc * 8; }
    const int woff = sr * 128 + ((sc ^ ((sr >> 1) & 7)) << 4);
    const int xs = (r32 >> 1) & 7;
    int rdo[4];
#pragma unroll
    for (int kk = 0; kk < 4; ++kk) rdo[kk] = (((kk * 2 + hi) ^ xs) << 4);
    const int arow = (wr * 128 + r32) * 128, brow = (wc * 32 + r32) * 128;
    f32x16 acc[4][2];
#pragma unroll
    for (int i = 0; i < 4; ++i)
#pragma unroll
        for (int j = 0; j < 2; ++j)
#pragma unroll
            for (int r = 0; r < 16; ++r) acc[i][j][r] = 0.f;
    u32x4 ra[4], rb[4];
#pragma unroll
    for (int i = 0; i < 4; ++i) { ra[i] = *(const u32x4*)(A + aoff[i]); rb[i] = *(const u32x4*)(Bt + boff[i]); }
#pragma unroll
    for (int i = 0; i < 4; ++i) { *(u32x4*)(lds + woff + i * 8192) = ra[i]; *(u32x4*)(lds + 32768 + woff + i * 8192) = rb[i]; }
    __syncthreads();
    for (int kt = 0; kt < nk; ++kt) {
        unsigned char* cur = lds + (kt & 1) * 65536; unsigned char* nxt = lds + ((kt + 1) & 1) * 65536;
        const bool more = kt + 1 < nk;
        if (more) {
            const int k0 = (kt + 1) * 64;
#pragma unroll
            for (int i = 0; i < 4; ++i) { ra[i] = *(const u32x4*)(A + aoff[i] + k0); rb[i] = *(const u32x4*)(Bt + boff[i] + k0); }
        }
#pragma unroll
        for (int kk = 0; kk < 4; ++kk) {
            bf16x8 af[4], bfr[2];
#pragma unroll
            for (int i = 0; i < 4; ++i) af[i] = *(const bf16x8*)(cur + arow + i * 4096 + rdo[kk]);
#pragma unroll
            for (int j = 0; j < 2; ++j) bfr[j] = *(const bf16x8*)(cur + 32768 + brow + j * 16384 + rdo[kk]);
#pragma unroll
            for (int i = 0; i < 4; ++i)
#pragma unroll
                for (int j = 0; j < 2; ++j) acc[i][j] = MFMA32(af[i], bfr[j], acc[i][j]);
        }
        if (more) {
#pragma unroll
            for (int i = 0; i < 4; ++i) { *(u32x4*)(nxt + woff + i * 8192) = ra[i]; *(u32x4*)(nxt + 32768 + woff + i * 8192) = rb[i]; }
        }
        __syncthreads();
    }
    int hiv = hi; asm volatile("" : "+v"(hiv));
    epi_all<EPI>(P, acc, b, m0, n0, g.Mtot, wr, wc, r32, hiv);
}

template <int EPI> DI void gemm_phase(const KP& P, const GP& g, unsigned char* lds, int bid, int G, int ubase = 0) {
    const int nu = g.nb * g.mt * g.nt, per = g.mt * g.nt;
    int u = bid; if (u < ubase) u += ((ubase - u + G - 1) / G) * G;
    for (; u < ubase + nu; u += G) {
        const int v = u - ubase, b = v / per, rem = v % per, pm = rem / g.nt, pn = rem % g.nt;
        gemm_unit<EPI>(P, g, b, pm, pn, lds);
    }
}

template <int OFF> DI s16x4 tr_read(int vb) { s16x4 r; asm volatile("ds_read_b64_tr_b16 %0, %1 offset:%2" : "=&v"(r) : "v"(vb), "i"(OFF) : "memory"); return r; }
DI int v_rd_base(int lane) { return ((lane & 3) << 3) | (((lane >> 2) & 3) << 6) | (((lane >> 4) & 1) << 5) | (((lane >> 5) & 1) << 8); }

template <int DVB, int D0> struct PVOne {
    static DI void run(f32x16& od, int vb, bf16x8 pa0, bf16x8 pa1, bf16x8 pa2, bf16x8 pa3) {
        constexpr int KSB = 2 * DVB * 512, HB = DVB * 512;
#define PKV(Lq, Hq) (bf16x8){Lq[0], Lq[1], Lq[2], Lq[3], Hq[0], Hq[1], Hq[2], Hq[3]}
        if constexpr (DVB == 4) {
            { const s16x4 l0 = tr_read<D0 * 512 + 0 * KSB>(vb), h0 = tr_read<D0 * 512 + 0 * KSB + HB>(vb);
              const s16x4 l1 = tr_read<D0 * 512 + 1 * KSB>(vb), h1 = tr_read<D0 * 512 + 1 * KSB + HB>(vb);
              asm volatile("s_waitcnt lgkmcnt(0)" ::: "memory"); __builtin_amdgcn_sched_barrier(0);
              od = MFMA32(pa0, PKV(l0, h0), od); od = MFMA32(pa1, PKV(l1, h1), od); }
            { const s16x4 l2 = tr_read<D0 * 512 + 2 * KSB>(vb), h2 = tr_read<D0 * 512 + 2 * KSB + HB>(vb);
              const s16x4 l3 = tr_read<D0 * 512 + 3 * KSB>(vb), h3 = tr_read<D0 * 512 + 3 * KSB + HB>(vb);
              asm volatile("s_waitcnt lgkmcnt(0)" ::: "memory"); __builtin_amdgcn_sched_barrier(0);
              od = MFMA32(pa2, PKV(l2, h2), od); od = MFMA32(pa3, PKV(l3, h3), od); }
        } else {
        const s16x4 l0 = tr_read<D0 * 512 + 0 * KSB>(vb), h0 = tr_read<D0 * 512 + 0 * KSB + HB>(vb);
        const s16x4 l1 = tr_read<D0 * 512 + 1 * KSB>(vb), h1 = tr_read<D0 * 512 + 1 * KSB + HB>(vb);
        const s16x4 l2 = tr_read<D0 * 512 + 2 * KSB>(vb), h2 = tr_read<D0 * 512 + 2 * KSB + HB>(vb);
        const s16x4 l3 = tr_read<D0 * 512 + 3 * KSB>(vb), h3 = tr_read<D0 * 512 + 3 * KSB + HB>(vb);
        asm volatile("s_waitcnt lgkmcnt(0)" ::: "memory"); __builtin_amdgcn_sched_barrier(0);
        od = MFMA32(pa0, PKV(l0, h0), od); od = MFMA32(pa1, PKV(l1, h1), od); od = MFMA32(pa2, PKV(l2, h2), od); od = MFMA32(pa3, PKV(l3, h3), od);
        }
#undef PKV
    }
};

#define SBAR() __builtin_amdgcn_sched_barrier(0)
DI void sm_partial(f32x16& p0) {
#pragma unroll
    for (int r = 0; r < 16; ++r) p0[r] = __builtin_amdgcn_exp2f(p0[r]);
}
DI void sm_finish(f32x16& p0, f32x16& p1, float& l_reg, bf16x8& pa0, bf16x8& pa1, bf16x8& pa2, bf16x8& pa3) {
#pragma unroll
    for (int r = 0; r < 16; ++r) p1[r] = __builtin_amdgcn_exp2f(p1[r]);
    float ps = 0.f;
#pragma unroll
    for (int r = 0; r < 16; ++r) ps += p0[r] + p1[r];
    l_reg += ps;
#define PK4(Pv, BASE, OUT) do { unsigned a0 = cvtpk(Pv[BASE + 0], Pv[BASE + 1]), a1 = cvtpk(Pv[BASE + 2], Pv[BASE + 3]);   \
    unsigned b0_ = cvtpk(Pv[BASE + 4], Pv[BASE + 5]), b1_ = cvtpk(Pv[BASE + 6], Pv[BASE + 7]);                              \
    auto r0 = __builtin_amdgcn_permlane32_swap(a0, b0_, false, false); auto r1 = __builtin_amdgcn_permlane32_swap(a1, b1_, false, false); \
    u32x4 w = {r0[0], r1[0], r0[1], r1[1]}; OUT = *reinterpret_cast<bf16x8*>(&w); } while (0)
    PK4(p0, 0, pa0); PK4(p0, 8, pa1); PK4(p1, 0, pa2); PK4(p1, 8, pa3);
#undef PK4
}
template <int DVB, int B> struct PVB {
    static constexpr int D0 = B % DVB, KH = B / DVB, KSB = 2 * DVB * 512, HB = DVB * 512;
    static DI void issue(int vb, s16x4 (&t)[4]) {
        t[0] = tr_read<D0 * 512 + (2 * KH) * KSB>(vb); t[1] = tr_read<D0 * 512 + (2 * KH) * KSB + HB>(vb);
        t[2] = tr_read<D0 * 512 + (2 * KH + 1) * KSB>(vb); t[3] = tr_read<D0 * 512 + (2 * KH + 1) * KSB + HB>(vb);
    }
    static DI void run(f32x16 (&o)[DVB], int vb, const bf16x8 (&pa)[4], s16x4 (&cur)[4]) {
        constexpr int NB = 2 * DVB;
        s16x4 nxt[4];
        if constexpr (B + 1 < NB) { PVB<DVB, B + 1>::issue(vb, nxt); asm volatile("s_waitcnt lgkmcnt(4)" ::: "memory"); }
        else asm volatile("s_waitcnt lgkmcnt(0)" ::: "memory");
        __builtin_amdgcn_sched_barrier(0);
#define PKV(Lq, Hq) (bf16x8){Lq[0], Lq[1], Lq[2], Lq[3], Hq[0], Hq[1], Hq[2], Hq[3]}
        o[D0] = MFMA32(pa[2 * KH], PKV(cur[0], cur[1]), o[D0]);
        o[D0] = MFMA32(pa[2 * KH + 1], PKV(cur[2], cur[3]), o[D0]);
#undef PKV
        if constexpr (B + 1 < NB) PVB<DVB, B + 1>::run(o, vb, pa, nxt);
    }
};

#define LASP __attribute__((address_space(3)))
template <int KS, int DVB>
DI void attn_core(const bf16_t* __restrict__ Qb, int ldq, const bf16_t* __restrict__ Kb, int ldk, const bf16_t* __restrict__ Vb, int ldv, int nkeys, float negMc,
                  f32x16 (&o)[DVB], float& l_out, unsigned char* lds) {
    constexpr int KA = 8192, KBB = (KS == 6) ? 4096 : 0, KTILE = KA + KBB, VTILE = 64 * DVB * 64, SLOT = KTILE + VTILE;
    constexpr int NKI = KTILE / 1024, NVI = VTILE / 1024;
    const int tid = tid_l(), lane = tid & 63, wid = __builtin_amdgcn_readfirstlane(tid >> 6), r32 = lane & 31, hi = lane >> 5;
    (void)negMc;
    bf16x8 qr[KS];
    { const bf16_t* Qw = Qb + (size_t)(wid * 32 + r32) * ldq + hi * 8;
#pragma unroll
      for (int d0 = 0; d0 < KS; ++d0) qr[d0] = *(const bf16x8*)(Qw + d0 * 16); }
#pragma unroll
    for (int d = 0; d < DVB; ++d)
#pragma unroll
        for (int r = 0; r < 16; ++r) o[d][r] = 0.f;
    float l_reg = 0.f;
    const f32x16 czero = {0.f, 0.f, 0.f, 0.f, 0.f, 0.f, 0.f, 0.f, 0.f, 0.f, 0.f, 0.f, 0.f, 0.f, 0.f, 0.f};
    int ksrc0, ksrc1 = 0, vsrc0, vsrc1 = 0;
    { const int p = wid * 64 + lane, row = p >> 3, slot = p & 7, ch = slot ^ ((row >> 1) & 7); ksrc0 = row * ldk + ch * 8; }
    if constexpr (KS == 6) { const int p = (wid & 3) * 64 + lane, row = p >> 2, slot = p & 3, ch = slot ^ ((row >> 2) & 3); ksrc1 = row * ldk + 64 + ch * 8; }
    { const int p = wid * 64 + lane, st = p >> 5, row8 = (p & 31) >> 2, piece = p & 3, kg_ = st / DVB, cb = st % DVB, kk = kg_ * 8 + row8;
      const int k = (kk & ~0xC) | ((kk & 4) << 1) | ((kk & 8) >> 1); vsrc0 = k * ldv + cb * 32 + piece * 8; }
    if constexpr (DVB == 4) { const int p = (wid + 8) * 64 + lane, st = p >> 5, row8 = (p & 31) >> 2, piece = p & 3, kg_ = st / DVB, cb = st % DVB, kk = kg_ * 8 + row8;
      const int k = (kk & ~0xC) | ((kk & 4) << 1) | ((kk & 8) >> 1); vsrc1 = k * ldv + cb * 32 + piece * 8; }
    const bool kb_wave = (KS == 6) && (wid < 4);
    constexpr int NSLOT = (KS == 6) ? 6 : 5, PD = NSLOT - 1;
    const int NT = nkeys / 64;
    LASP unsigned char* L3 = (LASP unsigned char*)lds;
#define A_ISSUE(j) do { const int sl_ = ((j) % NSLOT) * SLOT; const bf16_t* kt_ = Kb + (size_t)(j) * 64 * ldk; const bf16_t* vt_ = Vb + (size_t)(j) * 64 * ldv; \
        __builtin_amdgcn_global_load_lds((const unsigned*)(kt_ + ksrc0), (LASP unsigned*)(L3 + sl_ + wid * 1024), 16, 0, 0); \
        if (kb_wave) __builtin_amdgcn_global_load_lds((const unsigned*)(kt_ + ksrc1), (LASP unsigned*)(L3 + sl_ + KA + (wid & 3) * 1024), 16, 0, 0); \
        __builtin_amdgcn_global_load_lds((const unsigned*)(vt_ + vsrc0), (LASP unsigned*)(L3 + sl_ + KTILE + wid * 1024), 16, 0, 0); \
        if constexpr (DVB == 4) __builtin_amdgcn_global_load_lds((const unsigned*)(vt_ + vsrc1), (LASP unsigned*)(L3 + sl_ + KTILE + (wid + 8) * 1024), 16, 0, 0); } while (0)
#define A_WAIT1() do { if constexpr (DVB == 4) asm volatile("s_waitcnt vmcnt(%0)" :: "n"((PD - 1) * 3) : "memory"); \
        else { if (kb_wave) asm volatile("s_waitcnt vmcnt(%0)" :: "n"((PD - 1) * 3) : "memory"); else asm volatile("s_waitcnt vmcnt(%0)" :: "n"((PD - 1) * 2) : "memory"); } } while (0)
    const int kax = (r32 >> 1) & 7, kbx = (r32 >> 2) & 3;
    const int vb0 = (int)(uintptr_t)(lds + KTILE) + v_rd_base(lane);
    A_ISSUE(0);
#pragma unroll
    for (int t = 1; t < PD; ++t) if (t < NT) A_ISSUE(t);
    if (NT >= PD) A_WAIT1(); else asm volatile("s_waitcnt vmcnt(0)" ::: "memory");
    __builtin_amdgcn_s_barrier();
    for (int j = 0; j < NT; ++j) {
        if (j + PD < NT) A_ISSUE(j + PD);
        const unsigned char* Kt = lds + (j % NSLOT) * SLOT;
        f32x16 p0, p1;
        { const int off = ((hi ^ kax) << 4);
          const bf16x8 b0 = *(const bf16x8*)(Kt + r32 * 128 + off), b1 = *(const bf16x8*)(Kt + (32 + r32) * 128 + off);
          p0 = MFMA32(b0, qr[0], czero); p1 = MFMA32(b1, qr[0], czero); }
#pragma unroll
        for (int d0 = 1; d0 < 4; ++d0) { const int off = (((d0 * 2 + hi) ^ kax) << 4);
            const bf16x8 b0 = *(const bf16x8*)(Kt + r32 * 128 + off), b1 = *(const bf16x8*)(Kt + (32 + r32) * 128 + off);
            p0 = MFMA32(b0, qr[d0], p0); p1 = MFMA32(b1, qr[d0], p1); }
        if constexpr (KS == 6) {
#pragma unroll
            for (int d0 = 4; d0 < 6; ++d0) { const int off = ((((d0 - 4) * 2 + hi) ^ kbx) << 4);
                const bf16x8 b0 = *(const bf16x8*)(Kt + KA + r32 * 64 + off), b1 = *(const bf16x8*)(Kt + KA + (32 + r32) * 64 + off);
                p0 = MFMA32(b0, qr[d0], p0); p1 = MFMA32(b1, qr[d0], p1); }
        }
        const int vb = vb0 + (j % NSLOT) * SLOT;
        s16x4 tv0[4];
        __builtin_amdgcn_sched_barrier(0);
        PVB<DVB, 0>::issue(vb, tv0);
        float ps = 0.f;
#pragma unroll
        for (int r = 0; r < 16; ++r) { p0[r] = __builtin_amdgcn_exp2f(p0[r]); p1[r] = __builtin_amdgcn_exp2f(p1[r]); ps += p0[r] + p1[r]; }
        l_reg += ps;
        bf16x8 pa[4];
#define PK4(Pv, BASE, OUT) do { unsigned a0 = cvtpk(Pv[BASE + 0], Pv[BASE + 1]), a1 = cvtpk(Pv[BASE + 2], Pv[BASE + 3]);   \
    unsigned b0_ = cvtpk(Pv[BASE + 4], Pv[BASE + 5]), b1_ = cvtpk(Pv[BASE + 6], Pv[BASE + 7]);                              \
    auto r0 = __builtin_amdgcn_permlane32_swap(a0, b0_, false, false); auto r1 = __builtin_amdgcn_permlane32_swap(a1, b1_, false, false); \
    u32x4 w = {r0[0], r1[0], r0[1], r1[1]}; OUT = *reinterpret_cast<bf16x8*>(&w); } while (0)
        PK4(p0, 0, pa[0]); PK4(p0, 8, pa[1]); PK4(p1, 0, pa[2]); PK4(p1, 8, pa[3]);
#undef PK4
        PVB<DVB, 0>::run(o, vb, pa, tv0);
        if (j + PD < NT) A_WAIT1(); else asm volatile("s_waitcnt vmcnt(0)" ::: "memory");
        __builtin_amdgcn_s_barrier();
    }
#undef A_ISSUE
#undef A_WAIT1
    { auto rr = __builtin_amdgcn_permlane32_swap(__float_as_uint(l_reg), __float_as_uint(l_reg), false, false);
      l_out = __uint_as_float(rr[0]) + __uint_as_float(rr[1]); }
}

#define PIN(x) asm volatile("" : "+v"(x))
typedef short v4i16_t __attribute__((ext_vector_type(4)));
DI s16x4 vtr_ld(const unsigned char* p) { return __builtin_bit_cast(s16x4, __builtin_amdgcn_ds_read_tr16_b64_v4i16((__attribute__((address_space(3))) v4i16_t*)(unsigned)(uintptr_t)p)); }
DI void mla_core_hi(const bf16_t* __restrict__ Qb, const bf16_t* __restrict__ Kb, const bf16_t* __restrict__ Vb, int nkeys, f32x16 (&o)[2], float& l_out, unsigned char* lds) {
    constexpr int ldq = 768, ldk = 768, ldv = 512, KSL = 12288, VSL = 8192, LDS_K = 0, LDS_V = 3 * KSL;
    const int tid = tid_l(), lane = tid & 63, r32 = lane & 31, hi = lane >> 5; const int wid = __builtin_amdgcn_readfirstlane(tid >> 6);
    const int NT = nkeys / 64;
    LASP unsigned char* L3 = (LASP unsigned char*)lds;
    const bf16_t* ksrc0 = Kb + (size_t)lane * ldk + wid * 8;
    const bf16_t* ksrc1 = Kb + (size_t)lane * ldk + (8 + (wid & 3)) * 8;
    const bf16_t* vsrc = Vb + (size_t)(16 * (wid & 3) + (lane >> 2)) * ldv + (wid >> 2) * 32 + (lane & 3) * 8;
#define DMA_K(t, slot) do { __builtin_amdgcn_global_load_lds((const unsigned*)(ksrc0 + (size_t)(t) * 64 * ldk), (LASP unsigned*)(L3 + LDS_K + (slot) * KSL + wid * 1024), 16, 0, 0); \
                            __builtin_amdgcn_global_load_lds((const unsigned*)(ksrc1 + (size_t)(t) * 64 * ldk), (LASP unsigned*)(L3 + LDS_K + (slot) * KSL + (8 + (wid & 3)) * 1024), 16, 0, 0); } while (0)
#define DMA_V(t, slot) __builtin_amdgcn_global_load_lds((const unsigned*)(vsrc + (size_t)(t) * 64 * ldv), (LASP unsigned*)(L3 + LDS_V + (slot) * VSL + wid * 1024), 16, 0, 0)
#define WAIT_BAR(N) asm volatile("s_waitcnt vmcnt(" #N ") lgkmcnt(0)\n\ts_barrier" ::: "memory")
    const unsigned char* vp0 = lds + LDS_V + ((lane >> 4) & 1) * 32 + (lane & 3) * 8 + (4 * hi + ((lane & 15) >> 2)) * 64;
    const unsigned char* kp0 = lds + LDS_K + hi * 1024 + r32 * 16;
    DMA_K(0, 0); DMA_V(0, 0); DMA_K(1, 1);
    bf16x8 qr[6];
#pragma unroll
    for (int d0 = 0; d0 < 6; ++d0) qr[d0] = *(const bf16x8*)(Qb + (size_t)(wid * 32 + r32) * ldq + d0 * 16 + hi * 8);
    float l_reg = 0.f;
#pragma unroll
    for (int d = 0; d < 2; ++d)
#pragma unroll
        for (int r = 0; r < 16; ++r) o[d][r] = 0.f;
    const f32x16 zero16 = {0.f, 0.f, 0.f, 0.f, 0.f, 0.f, 0.f, 0.f, 0.f, 0.f, 0.f, 0.f, 0.f, 0.f, 0.f, 0.f};
    f32x16 pA0, pA1, pB0, pB1; bf16x8 kf[12]; s16x4 vlo[8], vhi[8]; u32x4 pw0, pw1, pw2, pw3;
    int sl_prev = 0, sl_cur = 0, sl_next = 1;
#define ROT() do { sl_prev = sl_cur; sl_cur = sl_next; sl_next = (sl_next == 2) ? 0 : sl_next + 1; } while (0)
#define KLOAD2(base, d0) do { kf[2 * (d0)] = *(const bf16x8*)((base) + (d0) * 2048); kf[2 * (d0) + 1] = *(const bf16x8*)((base) + (d0) * 2048 + 512); } while (0)
#define QKT(C0, C1) do { C0 = MFMA32(kf[0], qr[0], zero16); C1 = MFMA32(kf[1], qr[0], zero16); \
        _Pragma("unroll") for (int d0 = 1; d0 < 6; ++d0) { C0 = MFMA32(kf[2 * d0], qr[d0], C0); C1 = MFMA32(kf[2 * d0 + 1], qr[d0], C1); } } while (0)
    DMA_K(2, 2);
    WAIT_BAR(5);
    _Pragma("unroll") for (int d0 = 0; d0 < 6; ++d0) KLOAD2(kp0, d0);
    QKT(pA0, pA1);
#pragma unroll
    for (int r = 0; r < 16; ++r) pA0[r] = __builtin_amdgcn_exp2f(pA0[r]);
    WAIT_BAR(0);
    DMA_K(3, 0); DMA_V(1, 1); ROT();
    _Pragma("unroll") for (int d0 = 0; d0 < 6; ++d0) KLOAD2(kp0 + sl_cur * KSL, d0);
    WAIT_BAR(3);
#define PKW(Pv, i) cvtpk(Pv[i], Pv[(i) + 1])
#define PAF(k) __builtin_bit_cast(bf16x8, pw##k)
#define VFR(i) (bf16x8){vlo[i][0], vlo[i][1], vlo[i][2], vlo[i][3], vhi[i][0], vhi[i][1], vhi[i][2], vhi[i][3]}
#define VRD(i) do { vlo[i] = vtr_ld(vp_ + (((i) >> 2) * 4096 + ((i) & 3) * 1024)); vhi[i] = vtr_ld(vp_ + (((i) >> 2) * 4096 + ((i) & 3) * 1024 + 512)); } while (0)
#define KRD(G, d0) do { if (G) { KLOAD2(kp0 + sl_next * KSL, d0); SBAR(); } } while (0)
#define GAPA(MF, a0, a1, a2, a3, W0, W1, PW) do { MF; sacc += a0; sacc += a1; sacc += a2; sacc += a3; W0; W1; PIN(PW); PIN(sacc); SBAR(); } while (0)
#define GAPX(MF, X, i, a0, a1, a2, W0, PW) do { MF; X[i] = __builtin_amdgcn_exp2f(X[i]); X[(i) + 1] = __builtin_amdgcn_exp2f(X[(i) + 1]); X[(i) + 2] = __builtin_amdgcn_exp2f(X[(i) + 2]); X[(i) + 3] = __builtin_amdgcn_exp2f(X[(i) + 3]); \
        sacc += a0; sacc += a1; sacc += a2; W0; PIN(X); PIN(PW); PIN(sacc); SBAR(); } while (0)
#define GAPA32(MF, a0, a1, a2, W0, W1, PW) do { MF; sacc += a0; sacc += a1; sacc += a2; W0; W1; PIN(PW); PIN(sacc); SBAR(); } while (0)
#define GAPA21(MF, a0, a1, W0, PW) do { MF; sacc += a0; sacc += a1; W0; PIN(PW); PIN(sacc); SBAR(); } while (0)
#define GAPB(MF, X, i) do { MF; X[i] = __builtin_amdgcn_exp2f(X[i]); X[(i) + 1] = __builtin_amdgcn_exp2f(X[(i) + 1]); PIN(X); SBAR(); } while (0)
#define STEP(C0, C1, P0, P1, t, GK, GV, GL) do { SBAR(); \
    const unsigned char* vp_ = vp0 + sl_prev * VSL; \
    float sacc = P0[0] + P0[1]; \
      \
    VRD(0); SBAR(); GAPX(C0 = MFMA32(kf[0], qr[0], zero16), P1, 0,  P0[2], P0[3], P0[4],    pw0[0] = PKW(P0, 0), pw0); \
    VRD(4); SBAR(); GAPX(C1 = MFMA32(kf[1], qr[0], zero16), P1, 4,  P0[5], P0[6], P0[7],    pw0[1] = PKW(P0, 2), pw0); \
    VRD(1); SBAR(); GAPX(C0 = MFMA32(kf[2], qr[1], C0),    P1, 8,  P0[8], P0[9], P0[10],   pw0[2] = PKW(P0, 4), pw0); \
    VRD(5); SBAR(); GAPX(C1 = MFMA32(kf[3], qr[1], C1),    P1, 12, P0[11], P0[12], P0[13], pw0[3] = PKW(P0, 6), pw0); \
    VRD(2); SBAR(); GAPA32(C0 = MFMA32(kf[4], qr[2], C0),  P0[14], P0[15], P1[0],  pw1[0] = PKW(P0, 8),  pw1[1] = PKW(P0, 10), pw1); \
    VRD(6); SBAR(); GAPA32(C1 = MFMA32(kf[5], qr[2], C1),  P1[1], P1[2], P1[3],    pw1[2] = PKW(P0, 12), pw1[3] = PKW(P0, 14), pw1); \
    VRD(3); SBAR(); GAPA32(C0 = MFMA32(kf[6], qr[3], C0),  P1[4], P1[5], P1[6],    pw2[0] = PKW(P1, 0),  pw2[1] = PKW(P1, 2),  pw2); \
    VRD(7); SBAR(); GAPA32(C1 = MFMA32(kf[7], qr[3], C1),  P1[7], P1[8], P1[9],    pw2[2] = PKW(P1, 4),  pw2[3] = PKW(P1, 6),  pw2); \
    GAPA21(C0 = MFMA32(kf[8], qr[4], C0),  P1[10], P1[11], pw3[0] = PKW(P1, 8),  pw3); \
    GAPA21(C1 = MFMA32(kf[9], qr[4], C1),  P1[12], P1[13], pw3[1] = PKW(P1, 10), pw3); \
    GAPA21(C0 = MFMA32(kf[10], qr[5], C0), P1[14], P1[15], pw3[2] = PKW(P1, 12), pw3); \
    GAPA21(C1 = MFMA32(kf[11], qr[5], C1), 0.f, 0.f,       pw3[3] = PKW(P1, 14), pw3); \
    l_reg += sacc; \
    if (GK) DMA_K((t) + 3, sl_cur); if (GV) DMA_V((t) + 1, sl_next); \
    SBAR(); \
    GAPB(o[0] = MFMA32(PAF(0), VFR(0), o[0]), C0, 0);              KRD(GL, 0); GAPB(o[1] = MFMA32(PAF(0), VFR(4), o[1]), C0, 2); \
    KRD(GL, 1); GAPB(o[0] = MFMA32(PAF(1), VFR(1), o[0]), C0, 4);  KRD(GL, 2); GAPB(o[1] = MFMA32(PAF(1), VFR(5), o[1]), C0, 6); \
    KRD(GL, 3); GAPB(o[0] = MFMA32(PAF(2), VFR(2), o[0]), C0, 8);  KRD(GL, 4); GAPB(o[1] = MFMA32(PAF(2), VFR(6), o[1]), C0, 10); \
    KRD(GL, 5); GAPB(o[0] = MFMA32(PAF(3), VFR(3), o[0]), C0, 12);             GAPB(o[1] = MFMA32(PAF(3), VFR(7), o[1]), C0, 14); \
    } while (0)
    int t = 1;
    for (; t + 5 < NT; t += 2) {
        STEP(pB0, pB1, pA0, pA1, t, true, true, true);     WAIT_BAR(3); ROT();
        STEP(pA0, pA1, pB0, pB1, t + 1, true, true, true); WAIT_BAR(3); ROT();
    }
#define ENDW(tt) do { if ((tt) + 3 < NT) { WAIT_BAR(3); } else if ((tt) + 2 < NT) { WAIT_BAR(1); } else { WAIT_BAR(0); } } while (0)
    for (; t + 1 < NT; t += 2) {
        STEP(pB0, pB1, pA0, pA1, t, (t + 3 < NT), (t + 1 < NT), (t + 1 < NT));         ENDW(t);     ROT();
        STEP(pA0, pA1, pB0, pB1, t + 1, (t + 4 < NT), (t + 2 < NT), (t + 2 < NT));     ENDW(t + 1); ROT();
    }
    STEP(pB0, pB1, pA0, pA1, NT - 1, false, false, false);
    { float sacc = 0.f;
#pragma unroll
      for (int r = 0; r < 16; ++r) pB1[r] = __builtin_amdgcn_exp2f(pB1[r]);
#pragma unroll
      for (int r = 0; r < 16; ++r) sacc += pB0[r] + pB1[r];
      l_reg += sacc;
      pw0 = (u32x4){PKW(pB0, 0), PKW(pB0, 2), PKW(pB0, 4), PKW(pB0, 6)}; pw1 = (u32x4){PKW(pB0, 8), PKW(pB0, 10), PKW(pB0, 12), PKW(pB0, 14)};
      pw2 = (u32x4){PKW(pB1, 0), PKW(pB1, 2), PKW(pB1, 4), PKW(pB1, 6)}; pw3 = (u32x4){PKW(pB1, 8), PKW(pB1, 10), PKW(pB1, 12), PKW(pB1, 14)};
      const unsigned char* vp_ = vp0 + sl_cur * VSL; _Pragma("unroll") for (int i = 0; i < 8; ++i) VRD(i);
      o[0] = MFMA32(PAF(0), VFR(0), o[0]); o[1] = MFMA32(PAF(0), VFR(4), o[1]); o[0] = MFMA32(PAF(1), VFR(1), o[0]); o[1] = MFMA32(PAF(1), VFR(5), o[1]);
      o[0] = MFMA32(PAF(2), VFR(2), o[0]); o[1] = MFMA32(PAF(2), VFR(6), o[1]); o[0] = MFMA32(PAF(3), VFR(3), o[0]); o[1] = MFMA32(PAF(3), VFR(7), o[1]); }
    asm volatile("s_waitcnt vmcnt(0) lgkmcnt(0)\n\ts_barrier" ::: "memory");
    { auto rr = __builtin_amdgcn_permlane32_swap(__float_as_uint(l_reg), __float_as_uint(l_reg), false, false); l_out = __uint_as_float(rr[0]) + __uint_as_float(rr[1]); }
#undef DMA_K
#undef DMA_V
#undef WAIT_BAR
#undef ROT
#undef KLOAD2
#undef QKT
#undef PKW
#undef PAF
#undef VRD
#undef VFR
#undef KRD
#undef GAPA
#undef GAPX
#undef GAPA32
#undef GAPA21
#undef GAPB
#undef STEP
#undef ENDW
}

DI void glds16(const void* g, unsigned lds_base) {
    unsigned sv; asm volatile("s_mov_b32 %0, m0\n\ts_mov_b32 m0, %2\n\ts_nop 0\n\tglobal_load_lds_dwordx4 %1, off\n\ts_mov_b32 m0, %0" : "=&s"(sv) : "v"(g), "s"(lds_base) : "memory"); }
#define MFMA16(a, b, c) __builtin_amdgcn_mfma_f32_16x16x32_bf16((a), (b), (c), 0, 0, 0)
DI void mla_core_x(const bf16_t* __restrict__ Qb, const bf16_t* __restrict__ Kb, const bf16_t* __restrict__ Vb, int nkeys, f32x4 (&o)[4][2], float (&l_out)[2], unsigned char* lds) {
    constexpr int ldq = 768, ldk = 768, ldv = 512, KSL = 12288, VSL = 8192, LDS_K = 0, LDS_V = 3 * KSL;
    const int tid = tid_l(), lane = tid & 63, c16 = lane & 15, g = lane >> 4; const int wid = __builtin_amdgcn_readfirstlane(tid >> 6);
    const int NT = nkeys / 64;
    LASP unsigned char* L3 = (LASP unsigned char*)lds;
    const bf16_t* ksrc0 = Kb + (size_t)lane * ldk + wid * 8;
    const bf16_t* ksrc1 = Kb + (size_t)lane * ldk + (8 + (wid & 3)) * 8;
    const bf16_t* vsrc = Vb + (size_t)(16 * (wid & 3) + (lane >> 2)) * ldv + (wid >> 2) * 32 + ((lane & 3) ^ (((lane >> 4) & 1) << 1)) * 8;
    const unsigned l3b = (unsigned)(uintptr_t)L3;
#define DMA_K(t, slot) do { glds16(ksrc0 + (size_t)(t) * 64 * ldk, l3b + LDS_K + (slot) * KSL + wid * 1024); \
                            glds16(ksrc1 + (size_t)(t) * 64 * ldk, l3b + LDS_K + (slot) * KSL + (8 + (wid & 3)) * 1024); } while (0)
#define DMA_V(t, slot) glds16(vsrc + (size_t)(t) * 64 * ldv, l3b + LDS_V + (slot) * VSL + wid * 1024)
#define WAIT_BAR(N) asm volatile("s_waitcnt vmcnt(" #N ") lgkmcnt(0)\n\ts_barrier" ::: "memory")
    const unsigned char* vpE = lds + LDS_V + (4 * g + (c16 >> 2)) * 64 + (g & 1) * 32 + (c16 & 3) * 8;
    const unsigned char* vpO = lds + LDS_V + (4 * g + (c16 >> 2)) * 64 + ((g & 1) ^ 1) * 32 + (c16 & 3) * 8;
    const unsigned char* kp0 = lds + LDS_K + g * 1024 + c16 * 16;
    DMA_K(0, 0); DMA_V(0, 0); DMA_K(1, 1);
    bf16x8 qf[2][3];
#pragma unroll
    for (int qb = 0; qb < 2; ++qb)
#pragma unroll
        for (int ks = 0; ks < 3; ++ks) qf[qb][ks] = *(const bf16x8*)(Qb + (size_t)(wid * 32 + qb * 16 + c16) * ldq + ks * 32 + g * 8);
    f32x4 la0 = {0.f, 0.f, 0.f, 0.f}, la1 = {0.f, 0.f, 0.f, 0.f};
    const short one_ = (c16 == 0) ? (short)0x3F80 : (short)0; const bf16x8 ones_a = {one_, one_, one_, one_, one_, one_, one_, one_};
#pragma unroll
    for (int d = 0; d < 4; ++d)
#pragma unroll
        for (int qb = 0; qb < 2; ++qb) o[d][qb] = (f32x4){0.f, 0.f, 0.f, 0.f};
    const f32x4 zero4 = {0.f, 0.f, 0.f, 0.f};
    f32x4 SA[4][2], SB[4][2]; bf16x8 kf[4][3]; s16x4 vlo[4][2], vhi[4][2]; u32x4 pw[2][2];
    int sl_prev = 0, sl_cur = 0, sl_next = 1;
#define ROT() do { sl_prev = sl_cur; sl_cur = sl_next; sl_next = (sl_next == 2) ? 0 : sl_next + 1; } while (0)
#define KLD(base, kb, ks) kf[kb][ks] = *(const bf16x8*)((base) + (ks) * 4096 + (kb) * 256)
#define KLOADALL(base) do { _Pragma("unroll") for (int ks_ = 0; ks_ < 3; ++ks_) { _Pragma("unroll") for (int kb_ = 0; kb_ < 4; ++kb_) KLD(base, kb_, ks_); } } while (0)
    DMA_K(2, 2);
    WAIT_BAR(5);
    KLOADALL(kp0);
#pragma unroll
    for (int kb = 0; kb < 4; ++kb)
#pragma unroll
        for (int qb = 0; qb < 2; ++qb) { SA[kb][qb] = MFMA16(kf[kb][0], qf[qb][0], zero4); SA[kb][qb] = MFMA16(kf[kb][1], qf[qb][1], SA[kb][qb]); SA[kb][qb] = MFMA16(kf[kb][2], qf[qb][2], SA[kb][qb]); }
#pragma unroll
    for (int kb = 0; kb < 2; ++kb)
#pragma unroll
        for (int qb = 0; qb < 2; ++qb)
#pragma unroll
            for (int i = 0; i < 4; ++i) SA[kb][qb][i] = __builtin_amdgcn_exp2f(SA[kb][qb][i]);
    WAIT_BAR(0);
    DMA_K(3, 0); DMA_V(1, 1); ROT();
    KLOADALL(kp0 + sl_cur * KSL);
    WAIT_BAR(3);
#define EX(X, kb, qb, i) X[kb][qb][i] = __builtin_amdgcn_exp2f(X[kb][qb][i])
#define VRD(d, s2) do { const unsigned char* b_ = (((d) & 1) ? vpO : vpE) + sl_prev * VSL + ((d) >> 1) * 4096 + (s2) * 2048; vlo[d][s2] = vtr_ld(b_); vhi[d][s2] = vtr_ld(b_ + 1024); } while (0)
#define VFR(d, s2) (bf16x8){vlo[d][s2][0], vlo[d][s2][1], vlo[d][s2][2], vlo[d][s2][3], vhi[d][s2][0], vhi[d][s2][1], vhi[d][s2][2], vhi[d][s2][3]}
#define PAF(s2, qb) __builtin_bit_cast(bf16x8, pw[s2][qb])
#define QK(C, ks, kb, qb) C[kb][qb] = MFMA16(kf[kb][ks], qf[qb][ks], C[kb][qb])
#define QK0(C, kb, qb) C[kb][qb] = MFMA16(kf[kb][0], qf[qb][0], zero4)
#define GA0(MF, Pp, kb, qb, i, d, s2) do { MF; EX(Pp, kb, qb, i); EX(Pp, kb, qb, (i) + 1); VRD(d, s2); PIN(Pp[kb][qb]); SBAR(); } while (0)
#define GA1(MF, Pp, kb, qb, i, s2, w) do { MF; pw[s2][qb][w] = cvtpk(Pp[kb][qb][i], Pp[kb][qb][(i) + 1]); PIN(pw[s2][qb]); SBAR(); } while (0)
#define LS(s2) do { la0 = MFMA16(ones_a, PAF(s2, 0), la0); la1 = MFMA16(ones_a, PAF(s2, 1), la1); SBAR(); } while (0)
#define GB(MF, C, kb, qb, i) do { MF; EX(C, kb, qb, i); PIN(C[kb][qb]); SBAR(); } while (0)
#define PV(d, s2, qb) o[d][qb] = MFMA16(VFR(d, s2), PAF(s2, qb), o[d][qb])
#define KRD(G, kb, ks) do { if (G) { KLD(kp0 + sl_next * KSL, kb, ks); SBAR(); } } while (0)
#define STEP(C, Pp, t, GK, GV, GL) do { SBAR(); \
    GA0(QK0(C, 0, 0), Pp, 2, 0, 0, 0, 0); GA0(QK0(C, 0, 1), Pp, 2, 0, 2, 1, 0); GA0(QK0(C, 1, 0), Pp, 2, 1, 0, 2, 0); GA0(QK0(C, 1, 1), Pp, 2, 1, 2, 3, 0); \
    GA0(QK0(C, 2, 0), Pp, 3, 0, 0, 0, 1); GA0(QK0(C, 2, 1), Pp, 3, 0, 2, 1, 1); GA0(QK0(C, 3, 0), Pp, 3, 1, 0, 2, 1); GA0(QK0(C, 3, 1), Pp, 3, 1, 2, 3, 1); \
    GA1(QK(C, 1, 0, 0), Pp, 0, 0, 0, 0, 0); GA1(QK(C, 1, 0, 1), Pp, 0, 0, 2, 0, 1); GA1(QK(C, 1, 1, 0), Pp, 1, 0, 0, 0, 2); GA1(QK(C, 1, 1, 1), Pp, 1, 0, 2, 0, 3); \
    GA1(QK(C, 1, 2, 0), Pp, 0, 1, 0, 0, 0); GA1(QK(C, 1, 2, 1), Pp, 0, 1, 2, 0, 1); GA1(QK(C, 1, 3, 0), Pp, 1, 1, 0, 0, 2); GA1(QK(C, 1, 3, 1), Pp, 1, 1, 2, 0, 3); \
    GA1(QK(C, 2, 0, 0), Pp, 2, 0, 0, 1, 0); GA1(QK(C, 2, 0, 1), Pp, 2, 0, 2, 1, 1); GA1(QK(C, 2, 1, 0), Pp, 3, 0, 0, 1, 2); GA1(QK(C, 2, 1, 1), Pp, 3, 0, 2, 1, 3); \
    GA1(QK(C, 2, 2, 0), Pp, 2, 1, 0, 1, 0); GA1(QK(C, 2, 2, 1), Pp, 2, 1, 2, 1, 1); GA1(QK(C, 2, 3, 0), Pp, 3, 1, 0, 1, 2); GA1(QK(C, 2, 3, 1), Pp, 3, 1, 2, 1, 3); \
    if (GK) DMA_K((t) + 3, sl_cur); if (GV) DMA_V((t) + 1, sl_next); \
    SBAR(); \
    GB(PV(0, 0, 0), C, 0, 0, 0); GB(PV(0, 0, 1), C, 0, 0, 1); KRD(GL, 0, 0); GB(PV(1, 0, 0), C, 0, 0, 2); KRD(GL, 1, 0); GB(PV(1, 0, 1), C, 0, 0, 3); KRD(GL, 2, 0); \
    GB(PV(2, 0, 0), C, 0, 1, 0); KRD(GL, 3, 0); GB(PV(2, 0, 1), C, 0, 1, 1); KRD(GL, 0, 1); GB(PV(3, 0, 0), C, 0, 1, 2); KRD(GL, 1, 1); GB(PV(3, 0, 1), C, 0, 1, 3); KRD(GL, 2, 1); \
    LS(0); GB(PV(0, 1, 0), C, 1, 0, 0); KRD(GL, 3, 1); GB(PV(0, 1, 1), C, 1, 0, 1); KRD(GL, 0, 2); GB(PV(1, 1, 0), C, 1, 0, 2); KRD(GL, 1, 2); GB(PV(1, 1, 1), C, 1, 0, 3); KRD(GL, 2, 2); \
    GB(PV(2, 1, 0), C, 1, 1, 0); KRD(GL, 3, 2); GB(PV(2, 1, 1), C, 1, 1, 1); GB(PV(3, 1, 0), C, 1, 1, 2); GB(PV(3, 1, 1), C, 1, 1, 3); LS(1); \
    } while (0)
    int t = 1;
    for (; t + 5 < NT; t += 2) {
        STEP(SB, SA, t, true, true, true);     WAIT_BAR(3); ROT();
        STEP(SA, SB, t + 1, true, true, true); WAIT_BAR(3); ROT();
    }
#define ENDW(tt) do { if ((tt) + 3 < NT) { WAIT_BAR(3); } else if ((tt) + 2 < NT) { WAIT_BAR(1); } else { WAIT_BAR(0); } } while (0)
    for (; t + 1 < NT; t += 2) {
        STEP(SB, SA, t, (t + 3 < NT), (t + 1 < NT), (t + 1 < NT));         ENDW(t);     ROT();
        STEP(SA, SB, t + 1, (t + 4 < NT), (t + 2 < NT), (t + 2 < NT));     ENDW(t + 1); ROT();
    }
    STEP(SB, SA, NT - 1, false, false, false);
    { sl_prev = sl_cur;
#pragma unroll
      for (int kb = 2; kb < 4; ++kb)
#pragma unroll
          for (int qb = 0; qb < 2; ++qb)
#pragma unroll
              for (int i = 0; i < 4; ++i) EX(SB, kb, qb, i);
#pragma unroll
      for (int s2 = 0; s2 < 2; ++s2)
#pragma unroll
          for (int qb = 0; qb < 2; ++qb) pw[s2][qb] = (u32x4){cvtpk(SB[2 * s2][qb][0], SB[2 * s2][qb][1]), cvtpk(SB[2 * s2][qb][2], SB[2 * s2][qb][3]), cvtpk(SB[2 * s2 + 1][qb][0], SB[2 * s2 + 1][qb][1]), cvtpk(SB[2 * s2 + 1][qb][2], SB[2 * s2 + 1][qb][3])};
#pragma unroll
      for (int s2 = 0; s2 < 2; ++s2)
#pragma unroll
          for (int d = 0; d < 4; ++d) VRD(d, s2);
#pragma unroll
      for (int s2 = 0; s2 < 2; ++s2)
#pragma unroll
          for (int d = 0; d < 4; ++d) { PV(d, s2, 0); PV(d, s2, 1); }
      LS(0); LS(1); }
    asm volatile("s_waitcnt vmcnt(0) lgkmcnt(0)\n\ts_barrier" ::: "memory");
    l_out[0] = __shfl(la0[0], c16); l_out[1] = __shfl(la1[0], c16);
#undef DMA_K
#undef DMA_V
#undef WAIT_BAR
#undef ROT
#undef KLD
#undef KLOADALL
#undef EX
#undef VRD
#undef VFR
#undef PAF
#undef QK
#undef QK0
#undef GA0
#undef GA1
#undef LS
#undef GB
#undef PV
#undef KRD
#undef STEP
#undef ENDW
}

template <int B> struct PVB2 {
    static constexpr int DVB = 2, D0 = B % DVB, KH = B / DVB;
    static DI void run(f32x16 (&oa)[2], f32x16 (&ob)[2], int vb, const bf16x8 (&paa)[4], const bf16x8 (&pab)[4], s16x4 (&cur)[4]) {
        constexpr int NB = 2 * DVB;
        s16x4 nxt[4];
        if constexpr (B + 1 < NB) { PVB<DVB, B + 1>::issue(vb, nxt); asm volatile("s_waitcnt lgkmcnt(4)" ::: "memory"); }
        else asm volatile("s_waitcnt lgkmcnt(0)" ::: "memory");
        __builtin_amdgcn_sched_barrier(0);
#define PKV(Lq, Hq) (bf16x8){Lq[0], Lq[1], Lq[2], Lq[3], Hq[0], Hq[1], Hq[2], Hq[3]}
        const bf16x8 v0 = PKV(cur[0], cur[1]), v1 = PKV(cur[2], cur[3]);
#undef PKV
        oa[D0] = MFMA32(paa[2 * KH], v0, oa[D0]); ob[D0] = MFMA32(pab[2 * KH], v0, ob[D0]);
        oa[D0] = MFMA32(paa[2 * KH + 1], v1, oa[D0]); ob[D0] = MFMA32(pab[2 * KH + 1], v1, ob[D0]);
        if constexpr (B + 1 < NB) PVB2<B + 1>::run(oa, ob, vb, paa, pab, nxt);
    }
};
DI void mla_core64(const bf16_t* __restrict__ Qb, const bf16_t* __restrict__ Kb, const bf16_t* __restrict__ Vb, int nkeys,
                   f32x16 (&oa)[2], f32x16 (&ob)[2], float& la_out, float& lb_out, unsigned char* lds) {
    constexpr int KS = 6, DVB = 2, ldq = 768, ldk = 768, ldv = 512;
    constexpr int KA = 8192, KBB = 4096, KTILE = KA + KBB, VTILE = 64 * DVB * 64, SLOT = KTILE + VTILE;
    const int tid = tid_l(), lane = tid & 63, wid = __builtin_amdgcn_readfirstlane(tid >> 6), r32_ = lane & 31, hi_ = lane >> 5;
    bf16x8 qa[KS], qb_[KS];
    { const bf16_t* Qw = Qb + (size_t)(wid * 64 + r32_) * ldq + hi_ * 8;
#pragma unroll
      for (int d0 = 0; d0 < KS; ++d0) { qa[d0] = *(const bf16x8*)(Qw + d0 * 16); qb_[d0] = *(const bf16x8*)(Qw + (size_t)32 * ldq + d0 * 16); } }
#pragma unroll
    for (int d = 0; d < DVB; ++d)
#pragma unroll
        for (int r = 0; r < 16; ++r) { oa[d][r] = 0.f; ob[d][r] = 0.f; }
    float la = 0.f, lb = 0.f;
    const f32x16 czero = {0.f, 0.f, 0.f, 0.f, 0.f, 0.f, 0.f, 0.f, 0.f, 0.f, 0.f, 0.f, 0.f, 0.f, 0.f, 0.f};
    int ksrc0, ksrc1, vsrc0;
    { const int p = wid * 64 + lane, row = p >> 3, slot = p & 7, ch = slot ^ ((row >> 1) & 7); ksrc0 = row * ldk + ch * 8; }
    { const int p = (wid & 3) * 64 + lane, row = p >> 2, slot = p & 3, ch = slot ^ ((row >> 2) & 3); ksrc1 = row * ldk + 64 + ch * 8; }
    { const int p = wid * 64 + lane, st = p >> 5, row8 = (p & 31) >> 2, piece = p & 3, kg_ = st / DVB, cb = st % DVB, kk = kg_ * 8 + row8;
      const int k = (kk & ~0xC) | ((kk & 4) << 1) | ((kk & 8) >> 1); vsrc0 = k * ldv + cb * 32 + piece * 8; }
    const bool kb_wave = wid < 4;
    constexpr int NSLOT = 6, PD = NSLOT - 1;
    const int NT = nkeys / 64;
    LASP unsigned char* L3 = (LASP unsigned char*)lds;
#define M_ISSUE(j) do { const int sl_ = ((j) % NSLOT) * SLOT; const bf16_t* kt_ = Kb + (size_t)(j) * 64 * ldk; const bf16_t* vt_ = Vb + (size_t)(j) * 64 * ldv; \
        __builtin_amdgcn_global_load_lds((const unsigned*)(kt_ + ksrc0), (LASP unsigned*)(L3 + sl_ + wid * 1024), 16, 0, 0); \
        if (kb_wave) __builtin_amdgcn_global_load_lds((const unsigned*)(kt_ + ksrc1), (LASP unsigned*)(L3 + sl_ + KA + (wid & 3) * 1024), 16, 0, 0); \
        __builtin_amdgcn_global_load_lds((const unsigned*)(vt_ + vsrc0), (LASP unsigned*)(L3 + sl_ + KTILE + wid * 1024), 16, 0, 0); } while (0)
#define M_WAIT1() do { if (kb_wave) asm volatile("s_waitcnt vmcnt(%0)" :: "n"((PD - 1) * 3) : "memory"); else asm volatile("s_waitcnt vmcnt(%0)" :: "n"((PD - 1) * 2) : "memory"); } while (0)
    const int vb0 = (int)(uintptr_t)(lds + KTILE) + v_rd_base(lane);
    M_ISSUE(0);
#pragma unroll
    for (int t = 1; t < PD; ++t) if (t < NT) M_ISSUE(t);
    if (NT >= PD) M_WAIT1(); else asm volatile("s_waitcnt vmcnt(0)" ::: "memory");
    __builtin_amdgcn_s_barrier();
    for (int j = 0; j < NT; ++j) {
        if (j + PD < NT) M_ISSUE(j + PD);
        const unsigned char* Kt = lds + (j % NSLOT) * SLOT;
        int r32 = r32_, hi = hi_; asm volatile("" : "+v"(r32), "+v"(hi));
        const int kax = (r32 >> 1) & 7, kbx = (r32 >> 2) & 3;
        f32x16 pa0_, pa1_, pb0_, pb1_;
        { const int off = ((hi ^ kax) << 4);
          const bf16x8 b0 = *(const bf16x8*)(Kt + r32 * 128 + off), b1 = *(const bf16x8*)(Kt + (32 + r32) * 128 + off);
          pa0_ = MFMA32(b0, qa[0], czero); pb0_ = MFMA32(b0, qb_[0], czero); pa1_ = MFMA32(b1, qa[0], czero); pb1_ = MFMA32(b1, qb_[0], czero); }
#pragma unroll
        for (int d0 = 1; d0 < 4; ++d0) { const int off = (((d0 * 2 + hi) ^ kax) << 4);
            const bf16x8 b0 = *(const bf16x8*)(Kt + r32 * 128 + off), b1 = *(const bf16x8*)(Kt + (32 + r32) * 128 + off);
            pa0_ = MFMA32(b0, qa[d0], pa0_); pb0_ = MFMA32(b0, qb_[d0], pb0_); pa1_ = MFMA32(b1, qa[d0], pa1_); pb1_ = MFMA32(b1, qb_[d0], pb1_); }
#pragma unroll
        for (int d0 = 4; d0 < 6; ++d0) { const int off = ((((d0 - 4) * 2 + hi) ^ kbx) << 4);
            const bf16x8 b0 = *(const bf16x8*)(Kt + KA + r32 * 64 + off), b1 = *(const bf16x8*)(Kt + KA + (32 + r32) * 64 + off);
            pa0_ = MFMA32(b0, qa[d0], pa0_); pb0_ = MFMA32(b0, qb_[d0], pb0_); pa1_ = MFMA32(b1, qa[d0], pa1_); pb1_ = MFMA32(b1, qb_[d0], pb1_); }
        const int vb = vb0 + (j % NSLOT) * SLOT;
        s16x4 tv0[4];
        __builtin_amdgcn_sched_barrier(0);
        PVB<DVB, 0>::issue(vb, tv0);
        bf16x8 paa[4], pab[4];
#define PK4(Pv, BASE, OUT) do { unsigned a0 = cvtpk(Pv[BASE + 0], Pv[BASE + 1]), a1 = cvtpk(Pv[BASE + 2], Pv[BASE + 3]);   \
    unsigned b0_ = cvtpk(Pv[BASE + 4], Pv[BASE + 5]), b1_ = cvtpk(Pv[BASE + 6], Pv[BASE + 7]);                              \
    auto r0 = __builtin_amdgcn_permlane32_swap(a0, b0_, false, false); auto r1 = __builtin_amdgcn_permlane32_swap(a1, b1_, false, false); \
    u32x4 w = {r0[0], r1[0], r0[1], r1[1]}; OUT = *reinterpret_cast<bf16x8*>(&w); } while (0)
        { float ps = 0.f;
#pragma unroll
          for (int r = 0; r < 16; ++r) { pa0_[r] = __builtin_amdgcn_exp2f(pa0_[r]); pa1_[r] = __builtin_amdgcn_exp2f(pa1_[r]); ps += pa0_[r] + pa1_[r]; }
          la += ps; PK4(pa0_, 0, paa[0]); PK4(pa0_, 8, paa[1]); PK4(pa1_, 0, paa[2]); PK4(pa1_, 8, paa[3]); }
        { float ps = 0.f;
#pragma unroll
          for (int r = 0; r < 16; ++r) { pb0_[r] = __builtin_amdgcn_exp2f(pb0_[r]); pb1_[r] = __builtin_amdgcn_exp2f(pb1_[r]); ps += pb0_[r] + pb1_[r]; }
          lb += ps; PK4(pb0_, 0, pab[0]); PK4(pb0_, 8, pab[1]); PK4(pb1_, 0, pab[2]); PK4(pb1_, 8, pab[3]); }
#undef PK4
        PVB2<0>::run(oa, ob, vb, paa, pab, tv0);
        if (j + PD < NT) M_WAIT1(); else asm volatile("s_waitcnt vmcnt(0)" ::: "memory");
        __builtin_amdgcn_s_barrier();
    }
#undef M_ISSUE
#undef M_WAIT1
    { auto rr = __builtin_amdgcn_permlane32_swap(__float_as_uint(la), __float_as_uint(la), false, false); la_out = __uint_as_float(rr[0]) + __uint_as_float(rr[1]); }
    { auto rr = __builtin_amdgcn_permlane32_swap(__float_as_uint(lb), __float_as_uint(lb), false, false); lb_out = __uint_as_float(rr[0]) + __uint_as_float(rr[1]); }
}
DI void mla_attn_unit64(const KP& P, int qb, int h, unsigned char* lds) {
    const bf16_t* Q = (const bf16_t*)((const unsigned char*)P.out + O_Q0);
    const bf16_t* K = (const bf16_t*)(P.ws + R_G);
    const bf16_t* V = (const bf16_t*)(P.ws + R_F);
    const int q0 = qb * 512;
    f32x16 oa[2], ob[2]; float la, lb;
    mla_core64(Q + (size_t)q0 * 768 + h * 96, K + h * 96, V + h * 64, T, oa, ob, la, lb, lds);
    const int tid = tid_l(), lane = tid & 63, wid = tid >> 6, r32 = lane & 31, hi = lane >> 5;
    bf16_t* CAT = (bf16_t*)(P.ws + R_H);
    float* li = (float*)(lds + 122880) + wid * 64;
    if (hi == 0) { li[r32] = 1.f / la; li[32 + r32] = 1.f / lb; }
    asm volatile("s_waitcnt lgkmcnt(0)" ::: "memory");
    __builtin_amdgcn_wave_barrier();
#pragma unroll
    for (int r = 0; r < 16; ++r) { const int rr = crow(r, hi); const float ia = li[rr], ib = li[32 + rr]; const size_t row = (size_t)q0 + wid * 64 + rr;
#pragma unroll
        for (int d = 0; d < 2; ++d) { CAT[row * 1024 + h * 64 + d * 32 + r32] = f2bf(oa[d][r] * ia); CAT[(row + 32) * 1024 + h * 64 + d * 32 + r32] = f2bf(ob[d][r] * ib); } }
    __syncthreads();
}

DI void mla_attn_unit(const KP& P, int qb, int h, unsigned char* lds) {
    const bf16_t* Q = (const bf16_t*)((const unsigned char*)P.out + O_Q0);
    const bf16_t* K = (const bf16_t*)(P.ws + R_G);
    const bf16_t* V = (const bf16_t*)(P.ws + R_F);
    const int q0 = qb * 256; const bool isctx = q0 >= L;
    const int key0 = isctx ? L : 0, nkeys = isctx ? NC : T;
    f32x4 o[4][2]; float l[2];
    mla_core_x(Q + (size_t)q0 * 768 + h * 96, K + (size_t)key0 * 768 + h * 96, V + (size_t)key0 * 512 + h * 64, nkeys, o, l, lds);
    const int tid = tid_l(), lane = tid & 63, wid = tid >> 6, c16 = lane & 15, g = lane >> 4;
    bf16_t* CAT = (bf16_t*)(P.ws + R_H);
#pragma unroll
    for (int qq = 0; qq < 2; ++qq) { const float inv = 1.f / l[qq]; const size_t row = (size_t)q0 + wid * 32 + qq * 16 + c16;
#pragma unroll
        for (int d = 0; d < 4; ++d) { u32x2 w; w.x = cvtpk(o[d][qq][0] * inv, o[d][qq][1] * inv); w.y = cvtpk(o[d][qq][2] * inv, o[d][qq][3] * inv);
            *(u32x2*)(CAT + row * 1024 + h * 64 + d * 16 + 4 * g) = w; } }
    __syncthreads();
}

DI void diff_core_hi(const bf16_t* __restrict__ Qb, const bf16_t* __restrict__ Kb, const bf16_t* __restrict__ Vb, int nkeys, f32x16 (&o)[4], float& l_out, unsigned char* lds) {
    constexpr int ldq = 1024, ldk = 1024, ldv = 512, KSL = 8192, VSL = 16384, LDS_K = 0, LDS_V = 3 * KSL;
    const int tid = tid_l(), lane = tid & 63, r32 = lane & 31, hi = lane >> 5; const int wid = __builtin_amdgcn_readfirstlane(tid >> 6);
    const int NT = nkeys / 64;
    LASP unsigned char* L3 = (LASP unsigned char*)lds;
    const bf16_t* ksrc = Kb + (size_t)lane * ldk + wid * 8;
    const bf16_t* vsrc0 = Vb + (size_t)(16 * (wid & 3) + (lane >> 2)) * ldv + (wid >> 2) * 32 + (lane & 3) * 8;
    const bf16_t* vsrc1 = vsrc0 + 64;
#define DMA_K(t, slot) __builtin_amdgcn_global_load_lds((const unsigned*)(ksrc + (size_t)(t) * 64 * ldk), (LASP unsigned*)(L3 + LDS_K + (slot) * KSL + wid * 1024), 16, 0, 0)
#define DMA_V(t, slot) do { __builtin_amdgcn_global_load_lds((const unsigned*)(vsrc0 + (size_t)(t) * 64 * ldv), (LASP unsigned*)(L3 + LDS_V + (slot) * VSL + wid * 1024), 16, 0, 0); \
                            __builtin_amdgcn_global_load_lds((const unsigned*)(vsrc1 + (size_t)(t) * 64 * ldv), (LASP unsigned*)(L3 + LDS_V + (slot) * VSL + (wid + 8) * 1024), 16, 0, 0); } while (0)
#define WAIT_BAR(N) asm volatile("s_waitcnt vmcnt(" #N ") lgkmcnt(0)\n\ts_barrier" ::: "memory")
    const unsigned char* vp0 = lds + LDS_V + ((lane >> 4) & 1) * 32 + (lane & 3) * 8 + (4 * hi + ((lane & 15) >> 2)) * 64;
    const unsigned char* kp0 = lds + LDS_K + hi * 1024 + r32 * 16;
    DMA_K(0, 0); DMA_V(0, 0); DMA_K(1, 1);
    bf16x8 qr[4];
#pragma unroll
    for (int d0 = 0; d0 < 4; ++d0) qr[d0] = *(const bf16x8*)(Qb + (size_t)(wid * 32 + r32) * ldq + d0 * 16 + hi * 8);
    float l_reg = 0.f;
#pragma unroll
    for (int d = 0; d < 4; ++d)
#pragma unroll
        for (int r = 0; r < 16; ++r) o[d][r] = 0.f;
    const f32x16 zero16 = {0.f, 0.f, 0.f, 0.f, 0.f, 0.f, 0.f, 0.f, 0.f, 0.f, 0.f, 0.f, 0.f, 0.f, 0.f, 0.f};
    f32x16 pA0, pA1, pB0, pB1; bf16x8 kf[8]; s16x4 vlo[8], vhi[8]; u32x4 pw0, pw1, pw2, pw3;
    int sl_prev = 0, sl_cur = 0, sl_next = 1;
#define ROT() do { sl_prev = sl_cur; sl_cur = sl_next; sl_next = (sl_next == 2) ? 0 : sl_next + 1; } while (0)
#define KLOAD2(base, d0) do { kf[2 * (d0)] = *(const bf16x8*)((base) + (d0) * 2048); kf[2 * (d0) + 1] = *(const bf16x8*)((base) + (d0) * 2048 + 512); } while (0)
    DMA_K(2, 2);
    WAIT_BAR(4);
    _Pragma("unroll") for (int d0 = 0; d0 < 4; ++d0) KLOAD2(kp0, d0);
    pA0 = MFMA32(kf[0], qr[0], zero16); pA1 = MFMA32(kf[1], qr[0], zero16); pA0 = MFMA32(kf[2], qr[1], pA0); pA1 = MFMA32(kf[3], qr[1], pA1);
    pA0 = MFMA32(kf[4], qr[2], pA0); pA1 = MFMA32(kf[5], qr[2], pA1); pA0 = MFMA32(kf[6], qr[3], pA0); pA1 = MFMA32(kf[7], qr[3], pA1);
#pragma unroll
    for (int r = 0; r < 16; ++r) { pA0[r] = __builtin_amdgcn_exp2f(pA0[r]); pA1[r] = __builtin_amdgcn_exp2f(pA1[r]); }
    WAIT_BAR(0);
    DMA_K(3, 0); DMA_V(1, 1); ROT();
    _Pragma("unroll") for (int d0 = 0; d0 < 4; ++d0) KLOAD2(kp0 + sl_cur * KSL, d0);
    WAIT_BAR(3);
#define PKW(Pv, i) cvtpk(Pv[i], Pv[(i) + 1])
#define PAF(k) __builtin_bit_cast(bf16x8, pw##k)
#define VSL_(d0, ks) ((((ks) & 1) << 2) + (d0))
#define VRD(d0, ks) do { vlo[VSL_(d0, ks)] = vtr_ld(vp_ + (d0) * 4096 + (ks) * 1024); vhi[VSL_(d0, ks)] = vtr_ld(vp_ + (d0) * 4096 + (ks) * 1024 + 512); } while (0)
#define VFR2(d0, ks) (bf16x8){vlo[VSL_(d0, ks)][0], vlo[VSL_(d0, ks)][1], vlo[VSL_(d0, ks)][2], vlo[VSL_(d0, ks)][3], vhi[VSL_(d0, ks)][0], vhi[VSL_(d0, ks)][1], vhi[VSL_(d0, ks)][2], vhi[VSL_(d0, ks)][3]}
#define KRD(G, d0) do { if (G) { KLOAD2(kp0 + sl_next * KSL, d0); SBAR(); } } while (0)
#define GAPA(MF, a0, a1, a2, a3, W0, W1, PW) do { MF; sacc += a0; sacc += a1; sacc += a2; sacc += a3; W0; W1; PIN(PW); PIN(sacc); SBAR(); } while (0)
#define GAPB(d0, ks, X, i, NEXTRD) do { \
        o[d0] = MFMA32(PAF(ks), VFR2(d0, ks), o[d0]); X[i] = __builtin_amdgcn_exp2f(X[i]); X[(i) + 1] = __builtin_amdgcn_exp2f(X[(i) + 1]); PIN(X); SBAR(); } while (0)
#define STEP(C0, C1, P0, P1, t, GK, GV, GL) do { SBAR(); \
    const unsigned char* vp_ = vp0 + LDS_V - LDS_V + sl_prev * VSL; \
    float sacc = P0[0] + P0[1]; \
    VRD(0, 0); SBAR(); GAPA(C0 = MFMA32(kf[0], qr[0], zero16), P0[2], P0[3], P0[4], P0[5],     pw0[0] = PKW(P0, 0),  pw0[1] = PKW(P0, 2),  pw0); \
    VRD(1, 0); SBAR(); GAPA(C1 = MFMA32(kf[1], qr[0], zero16), P0[6], P0[7], P0[8], P0[9],     pw0[2] = PKW(P0, 4),  pw0[3] = PKW(P0, 6),  pw0); \
    VRD(2, 0); SBAR(); GAPA(C0 = MFMA32(kf[2], qr[1], C0),    P0[10], P0[11], P0[12], P0[13], pw1[0] = PKW(P0, 8),  pw1[1] = PKW(P0, 10), pw1); \
    VRD(3, 0); SBAR(); GAPA(C1 = MFMA32(kf[3], qr[1], C1),    P0[14], P0[15], P1[0], P1[1],   pw1[2] = PKW(P0, 12), pw1[3] = PKW(P0, 14), pw1); \
    VRD(0, 1); SBAR(); GAPA(C0 = MFMA32(kf[4], qr[2], C0),    P1[2], P1[3], P1[4], P1[5],     pw2[0] = PKW(P1, 0),  pw2[1] = PKW(P1, 2),  pw2); \
    VRD(1, 1); SBAR(); GAPA(C1 = MFMA32(kf[5], qr[2], C1),    P1[6], P1[7], P1[8], P1[9],     pw2[2] = PKW(P1, 4),  pw2[3] = PKW(P1, 6),  pw2); \
    VRD(2, 1); SBAR(); GAPA(C0 = MFMA32(kf[6], qr[3], C0),    P1[10], P1[11], P1[12], P1[13], pw3[0] = PKW(P1, 8),  pw3[1] = PKW(P1, 10), pw3); \
    VRD(3, 1); SBAR(); GAPA(C1 = MFMA32(kf[7], qr[3], C1),    P1[14], P1[15], 0.f, 0.f,       pw3[2] = PKW(P1, 12), pw3[3] = PKW(P1, 14), pw3); \
    l_reg += sacc; \
    if (GK) DMA_K((t) + 3, sl_cur); if (GV) DMA_V((t) + 1, sl_next); \
    SBAR(); \
      \
    GAPB(0, 0, C0, 0, 6);  VRD(0, 2); SBAR(); GAPB(1, 0, C0, 2, 6);  VRD(1, 2); SBAR(); GAPB(2, 0, C0, 4, 6);  VRD(2, 2); SBAR(); GAPB(3, 0, C0, 6, 6);  VRD(3, 2); SBAR(); \
    KRD(GL, 0); GAPB(0, 1, C0, 8, 6);  VRD(0, 3); SBAR(); GAPB(1, 1, C0, 10, 6); VRD(1, 3); SBAR(); GAPB(2, 1, C0, 12, 6); VRD(2, 3); SBAR(); GAPB(3, 1, C0, 14, 6); VRD(3, 3); SBAR(); \
    KRD(GL, 1); GAPB(0, 2, C1, 0, 6);  GAPB(1, 2, C1, 2, 6);  KRD(GL, 2); GAPB(2, 2, C1, 4, 6);  GAPB(3, 2, C1, 6, 6); \
    KRD(GL, 3); GAPB(0, 3, C1, 8, 6);  GAPB(1, 3, C1, 10, 4); GAPB(2, 3, C1, 12, 2); GAPB(3, 3, C1, 14, 0); \
    } while (0)
    int t = 1;
    for (; t + 5 < NT; t += 2) {
        STEP(pB0, pB1, pA0, pA1, t, true, true, true);     WAIT_BAR(3); ROT();
        STEP(pA0, pA1, pB0, pB1, t + 1, true, true, true); WAIT_BAR(3); ROT();
    }
#define ENDW(tt) do { if ((tt) + 3 < NT) { WAIT_BAR(3); } else if ((tt) + 2 < NT) { WAIT_BAR(2); } else { WAIT_BAR(0); } } while (0)
    for (; t + 1 < NT; t += 2) {
        STEP(pB0, pB1, pA0, pA1, t, (t + 3 < NT), (t + 1 < NT), (t + 1 < NT));         ENDW(t);     ROT();
        STEP(pA0, pA1, pB0, pB1, t + 1, (t + 4 < NT), (t + 2 < NT), (t + 2 < NT));     ENDW(t + 1); ROT();
    }
    STEP(pB0, pB1, pA0, pA1, NT - 1, false, false, false);
    { float sacc = 0.f;
#pragma unroll
      for (int r = 0; r < 16; ++r) sacc += pB0[r] + pB1[r];
      l_reg += sacc;
      pw0 = (u32x4){PKW(pB0, 0), PKW(pB0, 2), PKW(pB0, 4), PKW(pB0, 6)}; pw1 = (u32x4){PKW(pB0, 8), PKW(pB0, 10), PKW(pB0, 12), PKW(pB0, 14)};
      pw2 = (u32x4){PKW(pB1, 0), PKW(pB1, 2), PKW(pB1, 4), PKW(pB1, 6)}; pw3 = (u32x4){PKW(pB1, 8), PKW(pB1, 10), PKW(pB1, 12), PKW(pB1, 14)};
      const unsigned char* vp_ = vp0 + sl_cur * VSL;
#define DRAIN(ks) do { VRD(0, ks); VRD(1, ks); VRD(2, ks); VRD(3, ks); SBAR(); \
        o[0] = MFMA32(PAF(ks), VFR2(0, ks), o[0]); o[1] = MFMA32(PAF(ks), VFR2(1, ks), o[1]); o[2] = MFMA32(PAF(ks), VFR2(2, ks), o[2]); o[3] = MFMA32(PAF(ks), VFR2(3, ks), o[3]); SBAR(); } while (0)
      DRAIN(0); DRAIN(1); DRAIN(2); DRAIN(3);
#undef DRAIN
    }
    asm volatile("s_waitcnt vmcnt(0) lgkmcnt(0)\n\ts_barrier" ::: "memory");
    { auto rr = __builtin_amdgcn_permlane32_swap(__float_as_uint(l_reg), __float_as_uint(l_reg), false, false); l_out = __uint_as_float(rr[0]) + __uint_as_float(rr[1]); }
#undef DMA_K
#undef DMA_V
#undef WAIT_BAR
#undef ROT
#undef KLOAD2
#undef PKW
#undef PAF
#undef VRD
#undef VFR2
#undef VSL_
#undef KRD
#undef GAPA
#undef GAPB
#undef STEP
#undef ENDW
}

DI void diff_attn_unit(const KP& P, int qb, int h, unsigned char* lds) {
    const int q0 = qb * 256;
#pragma unroll 1
    for (int mp = 0; mp < 2; ++mp) {
        f32x16 o[4]; float l;
        { const bf16_t* QK = (const bf16_t*)(P.ws + R1_QK); const bf16_t* V = (const bf16_t*)(P.ws + R1_V);
          diff_core_hi(QK + (size_t)q0 * 1024 + h * 128 + mp * 64, QK + 512 + h * 128 + mp * 64, V + h * 128, T, o, l, lds); }
        const int tid = tid_l(), lane = tid & 63, wid = tid >> 6, r32 = lane & 31, hi = lane >> 5;
        bf16_t* CAT = (bf16_t*)(P.ws + R_H);
        float* li = (float*)(lds + 122880) + wid * 32;
        if (hi == 0) li[r32] = 1.f / l;
        asm volatile("s_waitcnt lgkmcnt(0)" ::: "memory");
        __builtin_amdgcn_wave_barrier();
        if (mp == 0) {
#pragma unroll
            for (int r = 0; r < 16; ++r) { const int rr = crow(r, hi); const float inv = li[rr]; const size_t row = (size_t)q0 + wid * 32 + rr;
#pragma unroll
                for (int d = 0; d < 4; ++d) CAT[row * 1024 + h * 128 + d * 32 + r32] = f2bf(o[d][r] * inv); }
        } else {
            const float lam = ((const float*)(P.ws + M_CONST))[2]; const float* g_o = P.in[35];
#pragma unroll
            for (int r = 0; r < 16; ++r) { const int rr = crow(r, hi); const float inv = li[rr]; const size_t row = (size_t)q0 + wid * 32 + rr;
                float dv[4]; float ss = 0.f;
#pragma unroll
                for (int d = 0; d < 4; ++d) { const float o1 = bf2f(CAT[row * 1024 + h * 128 + d * 32 + r32]); dv[d] = o1 - lam * o[d][r] * inv; ss += dv[d] * dv[d]; }
#pragma unroll
                for (int s_ = 1; s_ < 32; s_ <<= 1) ss += __shfl_xor(ss, s_);
                const float rstd = rsqrtf(ss * (1.f / 128.f) + EPS) * (1.f - LAM_INIT);
#pragma unroll
                for (int d = 0; d < 4; ++d) CAT[row * 1024 + h * 128 + d * 32 + r32] = f2bf(dv[d] * rstd * g_o[d * 32 + r32]); }
        }
        __syncthreads();
    }
}

DI void p0_ada_item(const KP& P, int item, unsigned char* lds) {
    const int layer = item / 96, cgp = item % 96, tid = threadIdx.x, col = tid & 63, ks = tid >> 6;
    const float* W = P.in[4] + (size_t)layer * 1024 * 6144 + cgp * 64 + col;
    const float* c = P.in[1]; const float* cc = P.in[3];
    float a0 = 0.f, a1 = 0.f;
#pragma unroll 32
    for (int k = ks * 128; k < ks * 128 + 128; ++k) { const float w = W[(size_t)k * 6144]; a0 += silu_f(c[k]) * w; a1 += silu_f(cc[k]) * w; }
    float* red = (float*)lds;
    red[(ks * 64 + col) * 2] = a0; red[(ks * 64 + col) * 2 + 1] = a1;
    __syncthreads();
    if (tid < 128) { const int cl = tid & 63, which = tid >> 6; float s = 0.f;
#pragma unroll
        for (int q = 0; q < 8; ++q) s += red[(q * 64 + cl) * 2 + which];
        const int n = cgp * 64 + cl;
        ((float*)(P.ws + M_MODS))[(layer * 2 + which) * 6144 + n] = s + P.in[5][layer * 6144 + n]; }
    __syncthreads();
}
DI void p0_transpose_item(const float* W, int K, int N, bf16_t* WT, int item, float* scr, int lane, int mode) {
    const int nblk = (N + 31) / 32, kb = item / nblk, nb = item % nblk, k0 = 64 * kb, n0 = 32 * nb;
    const bool nok = n0 + (lane & 31) < N;
#pragma unroll
    for (int i = 0; i < 32; ++i) { const int kk = 2 * i + (lane >> 5); scr[kk * 33 + (lane & 31)] = nok ? W[(size_t)(k0 + kk) * N + n0 + (lane & 31)] : 0.f; }
    asm volatile("s_waitcnt lgkmcnt(0)" ::: "memory"); __builtin_amdgcn_wave_barrier();
    const int c = lane & 7;
#pragma unroll
    for (int j = 0; j < 4; ++j) { const int n = (lane >> 3) + 8 * j; const float* s = scr + (8 * c) * 33 + n;
        u32x4 ov; ov.x = cvtpk(s[0 * 33], s[1 * 33]); ov.y = cvtpk(s[2 * 33], s[3 * 33]); ov.z = cvtpk(s[4 * 33], s[5 * 33]); ov.w = cvtpk(s[6 * 33], s[7 * 33]);
        int nn = n0 + n;
        if (mode == 1) nn = (nn >> 7) * 256 + (nn & 127);
        else if (mode == 2) nn = (nn >> 7) * 256 + 128 + (nn & 127);
        if (n0 + n < N) *(u32x4*)(WT + (size_t)nn * K + k0 + 8 * c) = ov; }
    asm volatile("s_waitcnt lgkmcnt(0)" ::: "memory"); __builtin_amdgcn_wave_barrier();
}
DI void p0_wmat(const float* W, bf16_t* WT, int K, int N, int mode, int& base, float* scr, int lane, int gw, int NGW) {
    const int ni = (K / 64) * ((N + 31) / 32);
    int i = gw; if (i < base) i += ((base - i + NGW - 1) / NGW) * NGW;
    for (; i < base + ni; i += NGW) p0_transpose_item(W, K, N, WT, i - base, scr, lane, mode);
    base += ni;
}
DI void p0_weights(const KP& P, unsigned char* lds, int gw, int NGW, int part) {
    const int lane = tid_l() & 63, wid = tid_l() >> 6;
    float* scr = (float*)(lds + 8192) + wid * (64 * 33);
    unsigned char* ws = P.ws;
    int base = 0;
    if (part == 0) {
    p0_wmat(P.in[9], (bf16_t*)(ws + W_IN0), 1024, 1184, 0, base, scr, lane, gw, NGW);
    p0_wmat(P.in[12], (bf16_t*)(ws + W_QB), 384, 768, 0, base, scr, lane, gw, NGW);
    p0_wmat(P.in[14], (bf16_t*)(ws + W_KVB), 256, 1024, 0, base, scr, lane, gw, NGW);
    p0_wmat(P.in[25], (bf16_t*)(ws + W_GLU), 512, 512, 0, base, scr, lane, gw, NGW);
    p0_wmat(P.in[10], (bf16_t*)(ws + W_OUT0), 1024, 1024, 0, base, scr, lane, gw, NGW);
    p0_wmat(P.in[6], (bf16_t*)(ws + W_13_0), 1024, 2816, 1, base, scr, lane, gw, NGW);
    p0_wmat(P.in[7], (bf16_t*)(ws + W_13_0), 1024, 2816, 2, base, scr, lane, gw, NGW);
    p0_wmat(P.in[8], (bf16_t*)(ws + W_2_0), 2816, 1024, 0, base, scr, lane, gw, NGW);
    p0_wmat(P.in[27], (bf16_t*)(ws + W_IN1), 1024, 3088, 0, base, scr, lane, gw, NGW);
    } else {
    p0_wmat(P.in[28], (bf16_t*)(ws + W_OUT1), 1024, 1024, 0, base, scr, lane, gw, NGW);
    p0_wmat(P.in[6] + (size_t)1024 * 2816, (bf16_t*)(ws + W_13_1), 1024, 2816, 1, base, scr, lane, gw, NGW);
    p0_wmat(P.in[7] + (size_t)1024 * 2816, (bf16_t*)(ws + W_13_1), 1024, 2816, 2, base, scr, lane, gw, NGW);
    p0_wmat(P.in[8] + (size_t)2816 * 1024, (bf16_t*)(ws + W_2_1), 2816, 1024, 0, base, scr, lane, gw, NGW);
    }
}
DI void p0_s5_tables(const KP& P, int item, unsigned char* lds) {
    const int d = item >> 5, g = item & 31, tid = threadIdx.x;
    float* apw = (float*)lds;
    float* bbs = apw + 33 * 64 * 2;
    float* Cs = bbs + 64 * 16 * 2;
    const int dg = d * 32 + g;
    if (tid < 64) {
        const int n = tid;
        const float dt = expf(P.in[19][dg]);
        const float lr = P.in[17][dg * 64 + n], li = P.in[18][dg * 64 + n];
        const float mag = expf(lr * dt), ang = li * dt;
        const float ar = mag * cosf(ang), ai = mag * sinf(ang);
        const float den = lr * lr + li * li;
        const float kr = ((ar - 1.f) * lr + ai * li) / den, ki = (ai * lr - (ar - 1.f) * li) / den;
        float pr = 1.f, pi = 0.f;
        for (int t = 0; t <= 32; ++t) { apw[(t * 64 + n) * 2] = pr; apw[(t * 64 + n) * 2 + 1] = pi; const float nr = pr * ar - pi * ai, ni = pr * ai + pi * ar; pr = nr; pi = ni; }
        for (int c = 0; c < 16; ++c) { const float br = P.in[20][(dg * 64 + n) * 16 + c], bi = P.in[21][(dg * 64 + n) * 16 + c];
            bbs[(n * 16 + c) * 2] = kr * br - ki * bi; bbs[(n * 16 + c) * 2 + 1] = kr * bi + ki * br; }
    }
    for (int i = tid; i < 1024; i += NTHREADS) { Cs[i * 2] = P.in[22][dg * 1024 + i]; Cs[i * 2 + 1] = P.in[23][dg * 1024 + i]; }
    __syncthreads();
    float* APOW = (float*)(P.ws + M_APOW) + (size_t)dg * 33 * 64 * 2;
    float* BB = (float*)(P.ws + M_BB) + (size_t)dg * 64 * 16 * 2;
    float* KT = (float*)(P.ws + M_KT) + (size_t)dg * 32 * 256;
    for (int i = tid; i < 33 * 64 * 2; i += NTHREADS) APOW[i] = apw[i];
    for (int i = tid; i < 64 * 16 * 2; i += NTHREADS) BB[i] = bbs[i];
    for (int i = tid; i < 32 * 256; i += NTHREADS) {
        const int tau = i >> 8, c = (i >> 4) & 15, cp = i & 15; float s = 0.f;
        for (int n = 0; n < 64; ++n) {
            const float cr = Cs[(c * 64 + n) * 2], ci = Cs[(c * 64 + n) * 2 + 1], pr = apw[(tau * 64 + n) * 2], pi = apw[(tau * 64 + n) * 2 + 1];
            const float br = bbs[(n * 16 + cp) * 2], bi = bbs[(n * 16 + cp) * 2 + 1];
            const float zr = cr * pr - ci * pi, zi = cr * pi + ci * pr;
            s += zr * br - zi * bi;
        }
        KT[i] = s;
    }
    __syncthreads();
}
DI void p0_consts(const KP& P) {
    const int tid = threadIdx.x;
    float* R16 = (float*)(P.ws + M_ROPE16); float* R8 = (float*)(P.ws + M_ROPE8);
    for (int i = tid; i < 256 * 16; i += NTHREADS) { const int pos = i >> 4, f = i & 15; const float inv = exp2f(-(float)f * (1.f / 16.f) * 13.287712379549449f);
        const float ang = (float)pos * inv; R16[i * 2] = cosf(ang); R16[i * 2 + 1] = sinf(ang); }
    for (int i = tid; i < 256 * 8; i += NTHREADS) { const int pos = i >> 3, f = i & 7; const float inv = exp2f(-(float)f * (1.f / 8.f) * 13.287712379549449f);
        const float ang = (float)pos * inv; R8[i * 2] = cosf(ang); R8[i * 2 + 1] = sinf(ang); }
    if (tid == 0) {
        float* cst = (float*)(P.ws + M_CONST);
        float mq = 0.f, mk = 0.f; for (int i = 0; i < 96; ++i) { mq = fmaxf(mq, fabsf(P.in[15][i])); mk = fmaxf(mk, fabsf(P.in[16][i])); }
        cst[0] = mq * mk * 9.797958971132712f * LOG2E;
        mq = 0.f; mk = 0.f; for (int i = 0; i < 64; ++i) { mq = fmaxf(mq, fabsf(P.in[29][i])); mk = fmaxf(mk, fabsf(P.in[30][i])); }
        cst[1] = mq * mk * 8.f * LOG2E;
        float s1 = 0.f, s2 = 0.f; for (int i = 0; i < 64; ++i) { s1 += P.in[31][i] * P.in[32][i]; s2 += P.in[33][i] * P.in[34][i]; }
        cst[2] = expf(s1) - expf(s2) + LAM_INIT;
    }
}

DI void modulate_rows(const KP& P, const float* xlat, const float* xctx, int layer, int shift_idx, int nrows, int gw_, int NGW) {
    const int lane = tid_l() & 63;
    bf16_t* __restrict__ H = (bf16_t*)(P.ws + R_A);
    const float* mods = (const float*)(P.ws + M_MODS);
    for (int row0 = gw_; row0 < nrows; row0 += 2 * NGW) {
        const int row1 = row0 + NGW; const bool has1 = row1 < nrows;
        const int r1 = has1 ? row1 : row0;
        const float* __restrict__ s0 = row0 < L ? xlat + (size_t)row0 * 1024 : xctx + (size_t)(row0 - L) * 1024;
        const float* __restrict__ s1 = r1 < L ? xlat + (size_t)r1 * 1024 : xctx + (size_t)(r1 - L) * 1024;
        f32x4 v0[4], v1[4];
#pragma unroll
        for (int j = 0; j < 4; ++j) { v0[j] = *(const f32x4*)(s0 + 4 * lane + 256 * j); v1[j] = *(const f32x4*)(s1 + 4 * lane + 256 * j); }
        float ss0 = 0.f, ss1 = 0.f;
#pragma unroll
        for (int j = 0; j < 4; ++j) { ss0 += v0[j].x * v0[j].x + v0[j].y * v0[j].y + v0[j].z * v0[j].z + v0[j].w * v0[j].w; ss1 += v1[j].x * v1[j].x + v1[j].y * v1[j].y + v1[j].z * v1[j].z + v1[j].w * v1[j].w; }
        const float rstd0 = rsqrtf(wave_sum(ss0) * (1.f / 1024.f) + EPS), rstd1 = rsqrtf(wave_sum(ss1) * (1.f / 1024.f) + EPS);
        const float* md0 = mods + (layer * 2 + (row0 < L ? 0 : 1)) * 6144; const float* md1 = mods + (layer * 2 + (r1 < L ? 0 : 1)) * 6144;
#pragma unroll
        for (int j = 0; j < 4; ++j) { const int c = 4 * lane + 256 * j;
            { const f32x4 sh = *(const f32x4*)(md0 + shift_idx * 1024 + c), sc = *(const f32x4*)(md0 + (shift_idx + 1) * 1024 + c);
              u32x2 w; w.x = cvtpk(v0[j].x * rstd0 * (1.f + sc.x) + sh.x, v0[j].y * rstd0 * (1.f + sc.y) + sh.y); w.y = cvtpk(v0[j].z * rstd0 * (1.f + sc.z) + sh.z, v0[j].w * rstd0 * (1.f + sc.w) + sh.w);
              *(u32x2*)(H + (size_t)row0 * 1024 + c) = w; }
            if (has1) { const f32x4 sh = *(const f32x4*)(md1 + shift_idx * 1024 + c), sc = *(const f32x4*)(md1 + (shift_idx + 1) * 1024 + c);
              u32x2 w; w.x = cvtpk(v1[j].x * rstd1 * (1.f + sc.x) + sh.x, v1[j].y * rstd1 * (1.f + sc.y) + sh.y); w.y = cvtpk(v1[j].z * rstd1 * (1.f + sc.z) + sh.z, v1[j].w * rstd1 * (1.f + sc.w) + sh.w);
              *(u32x2*)(H + (size_t)row1 * 1024 + c) = w; } }
    }
}
DI void p3_norm_rows(const KP& P, int gw_, int NGW) {
    const int lane = tid_l() & 63;
    bf16_t* Z0 = (bf16_t*)(P.ws + R_B);
    float gq[6], gk[4];
#pragma unroll
    for (int e = 0; e < 6; ++e) gq[e] = P.in[11][6 * lane + e];
#pragma unroll
    for (int e = 0; e < 4; ++e) gk[e] = P.in[13][4 * lane + e];
    for (int row0 = gw_; row0 < T; row0 += 2 * NGW) {
        const int row1 = row0 + NGW; const bool has1 = row1 < T; const int r1 = has1 ? row1 : row0;
        unsigned* q0p = (unsigned*)(Z0 + (size_t)row0 * 672 + 6 * lane); unsigned* q1p = (unsigned*)(Z0 + (size_t)r1 * 672 + 6 * lane);
        u32x2* k0p = (u32x2*)(Z0 + (size_t)row0 * 672 + 384 + 4 * lane); u32x2* k1p = (u32x2*)(Z0 + (size_t)r1 * 672 + 384 + 4 * lane);
        unsigned a0[3], a1[3]; u32x2 b0, b1;
#pragma unroll
        for (int e = 0; e < 3; ++e) { a0[e] = q0p[e]; a1[e] = q1p[e]; }
        b0 = *k0p; b1 = *k1p;
        float q0[6], q1[6], k0[4], k1[4];
#pragma unroll
        for (int e = 0; e < 3; ++e) { q0[2 * e] = bflo(a0[e]); q0[2 * e + 1] = bfhi(a0[e]); q1[2 * e] = bflo(a1[e]); q1[2 * e + 1] = bfhi(a1[e]); }
        k0[0] = bflo(b0.x); k0[1] = bfhi(b0.x); k0[2] = bflo(b0.y); k0[3] = bfhi(b0.y);
        k1[0] = bflo(b1.x); k1[1] = bfhi(b1.x); k1[2] = bflo(b1.y); k1[3] = bfhi(b1.y);
        float sq0 = 0.f, sq1 = 0.f, sk0 = 0.f, sk1 = 0.f;
#pragma unroll
        for (int e = 0; e < 6; ++e) { sq0 += q0[e] * q0[e]; sq1 += q1[e] * q1[e]; }
#pragma unroll
        for (int e = 0; e < 4; ++e) { sk0 += k0[e] * k0[e]; sk1 += k1[e] * k1[e]; }
        const float rq0 = rsqrtf(wave_sum(sq0) * (1.f / 384.f) + EPS), rq1 = rsqrtf(wave_sum(sq1) * (1.f / 384.f) + EPS);
        const float rk0 = rsqrtf(wave_sum(sk0) * (1.f / 256.f) + EPS), rk1 = rsqrtf(wave_sum(sk1) * (1.f / 256.f) + EPS);
#pragma unroll
        for (int e = 0; e < 3; ++e) q0p[e] = cvtpk(q0[2 * e] * rq0 * gq[2 * e], q0[2 * e + 1] * rq0 * gq[2 * e + 1]);
        { u32x2 w; w.x = cvtpk(k0[0] * rk0 * gk[0], k0[1] * rk0 * gk[1]); w.y = cvtpk(k0[2] * rk0 * gk[2], k0[3] * rk0 * gk[3]); *k0p = w; }
        if (has1) {
#pragma unroll
            for (int e = 0; e < 3; ++e) q1p[e] = cvtpk(q1[2 * e] * rq1 * gq[2 * e], q1[2 * e + 1] * rq1 * gq[2 * e + 1]);
            u32x2 w; w.x = cvtpk(k1[0] * rk1 * gk[0], k1[1] * rk1 * gk[1]); w.y = cvtpk(k1[2] * rk1 * gk[2], k1[3] * rk1 * gk[3]); *k1p = w; }
    }
}
DI void p5_finalize_rows(const KP& P, int gw, int NGW) {
    const int lane = tid_l() & 63;
    bf16_t* Q0 = (bf16_t*)((unsigned char*)P.out + O_Q0);
    const bf16_t* KN = (const bf16_t*)((const unsigned char*)P.out + O_KN);
    const bf16_t* Z0 = (const bf16_t*)(P.ws + R_B);
    bf16_t* K0 = (bf16_t*)(P.ws + R_G);
    const float* R8 = (const float*)(P.ws + M_ROPE8);
    const float* gqn = P.in[15]; const float* gkn = P.in[16];
    const int h = lane / 6, j = lane % 6; const bool act = lane < 48;
    const float qscale = 0.10206207261596577f * LOG2E;
    for (int row = gw; row < T; row += NGW) {
        const bool lat = row < L; const int prow = (row >> 6) & 255, pcol = row & 63;
        float q[16], k[16]; float sq = 0.f, sk = 0.f;
        if (act) {
            const u32x4 a = *(const u32x4*)(Q0 + (size_t)row * 768 + h * 96 + j * 16), b = *(const u32x4*)(Q0 + (size_t)row * 768 + h * 96 + j * 16 + 8);
            const unsigned wq[8] = {a.x, a.y, a.z, a.w, b.x, b.y, b.z, b.w};
#pragma unroll
            for (int i = 0; i < 8; ++i) { q[2 * i] = bflo(wq[i]); q[2 * i + 1] = bfhi(wq[i]); }
            const bf16_t* ksrc = j < 4 ? KN + (size_t)row * 512 + h * 64 + j * 16 : Z0 + (size_t)row * 672 + 640 + (j - 4) * 16;
            const u32x4 c = *(const u32x4*)(ksrc), d = *(const u32x4*)(ksrc + 8);
            const unsigned wk[8] = {c.x, c.y, c.z, c.w, d.x, d.y, d.z, d.w};
#pragma unroll
            for (int i = 0; i < 8; ++i) { k[2 * i] = bflo(wk[i]); k[2 * i + 1] = bfhi(wk[i]); }
#pragma unroll
            for (int i = 0; i < 16; ++i) { sq += q[i] * q[i]; sk += k[i] * k[i]; }
        } else {
#pragma unroll
            for (int i = 0; i < 16; ++i) { q[i] = 0.f; k[i] = 0.f; }
        }
        float tq = 0.f, tk = 0.f;
#pragma unroll
        for (int i = 0; i < 6; ++i) { tq += __shfl(sq, h * 6 + i); tk += __shfl(sk, h * 6 + i); }
        const float rq = rsqrtf(tq * (1.f / 96.f) + EPS), rk = rsqrtf(tk * (1.f / 96.f) + EPS);
        if (act) {
#pragma unroll
            for (int i = 0; i < 16; ++i) { q[i] *= rq * gqn[j * 16 + i]; k[i] *= rk * gkn[j * 16 + i]; }
            if (lat && j >= 4) {
                const int pos = (j == 4) ? prow : pcol;
#pragma unroll
                for (int i = 0; i < 8; ++i) { const float cs = R8[(pos * 8 + i) * 2], sn = R8[(pos * 8 + i) * 2 + 1];
                    const float q1 = q[i], q2 = q[i + 8], k1 = k[i], k2 = k[i + 8];
                    q[i] = q1 * cs - q2 * sn; q[i + 8] = q1 * sn + q2 * cs; k[i] = k1 * cs - k2 * sn; k[i + 8] = k1 * sn + k2 * cs; }
            }
            u32x4 oa, ob, oc, od;
            oa.x = cvtpk(q[0] * qscale, q[1] * qscale); oa.y = cvtpk(q[2] * qscale, q[3] * qscale); oa.z = cvtpk(q[4] * qscale, q[5] * qscale); oa.w = cvtpk(q[6] * qscale, q[7] * qscale);
            ob.x = cvtpk(q[8] * qscale, q[9] * qscale); ob.y = cvtpk(q[10] * qscale, q[11] * qscale); ob.z = cvtpk(q[12] * qscale, q[13] * qscale); ob.w = cvtpk(q[14] * qscale, q[15] * qscale);
            oc.x = cvtpk(k[0], k[1]); oc.y = cvtpk(k[2], k[3]); oc.z = cvtpk(k[4], k[5]); oc.w = cvtpk(k[6], k[7]);
            od.x = cvtpk(k[8], k[9]); od.y = cvtpk(k[10], k[11]); od.z = cvtpk(k[12], k[13]); od.w = cvtpk(k[14], k[15]);
            *(u32x4*)(Q0 + (size_t)row * 768 + h * 96 + j * 16) = oa; *(u32x4*)(Q0 + (size_t)row * 768 + h * 96 + j * 16 + 8) = ob;
            *(u32x4*)(K0 + (size_t)row * 768 + h * 96 + j * 16) = oc; *(u32x4*)(K0 + (size_t)row * 768 + h * 96 + j * 16 + 8) = od;
        }
    }
}
DI void p13_finalize_rows(const KP& P, int gw, int NGW) {
    const int lane = tid_l() & 63;
    bf16_t* QK = (bf16_t*)(P.ws + R1_QK);
    const float* R16 = (const float*)(P.ws + M_ROPE16);
    const int sl = lane & 3;
    const bool isq = lane < 32;
    const float* gain = isq ? P.in[29] : P.in[30];
    const float qscale = 0.125f * LOG2E;
    for (int row = gw; row < T; row += NGW) {
        const bool lat = row < L; const int prow = (row >> 6) & 255, pcol = row & 63;
        bf16_t* p = QK + (size_t)row * 1024 + lane * 16;
        const u32x4 a = *(const u32x4*)p, b = *(const u32x4*)(p + 8);
        const unsigned w[8] = {a.x, a.y, a.z, a.w, b.x, b.y, b.z, b.w};
        float x[16]; float ss = 0.f;
#pragma unroll
        for (int i = 0; i < 8; ++i) { x[2 * i] = bflo(w[i]); x[2 * i + 1] = bfhi(w[i]); }
#pragma unroll
        for (int i = 0; i < 16; ++i) ss += x[i] * x[i];
        ss += __shfl_xor(ss, 1); ss += __shfl_xor(ss, 2);
        const float rstd = rsqrtf(ss * (1.f / 64.f) + EPS);
#pragma unroll
        for (int i = 0; i < 16; ++i) x[i] *= rstd * gain[sl * 16 + i];
        if (lat) {
            const int pos = (sl < 2) ? prow : pcol; const bool first = (sl & 1) == 0;
#pragma unroll
            for (int i = 0; i < 16; ++i) { const float other = __shfl_xor(x[i], 1); const float cs = R16[(pos * 16 + i) * 2], sn = R16[(pos * 16 + i) * 2 + 1];
                x[i] = first ? (x[i] * cs - other * sn) : (other * sn + x[i] * cs); }
        }
        const float s = isq ? qscale : 1.f;
        u32x4 oa, ob;
        oa.x = cvtpk(x[0] * s, x[1] * s); oa.y = cvtpk(x[2] * s, x[3] * s); oa.z = cvtpk(x[4] * s, x[5] * s); oa.w = cvtpk(x[6] * s, x[7] * s);
        ob.x = cvtpk(x[8] * s, x[9] * s); ob.y = cvtpk(x[10] * s, x[11] * s); ob.z = cvtpk(x[12] * s, x[13] * s); ob.w = cvtpk(x[14] * s, x[15] * s);
        *(u32x4*)p = oa; *(u32x4*)(p + 8) = ob;
    }
}

DI void s5_expand(const KP& P, int gtid, int NGT) {
    const float* APOW = (const float*)(P.ws + M_APOW); const float* BB = (const float*)(P.ws + M_BB); const float* KT = (const float*)(P.ws + M_KT);
    const float* Cre = P.in[22]; const float* Cim = P.in[23]; const float* dsk = P.in[24];
    bf16_t* ME = (bf16_t*)(P.ws + R_D); bf16_t* BM = (bf16_t*)(P.ws + R_D2);
    const int NME = 32 * S5N * (S5K / 2);
#pragma unroll 4
    for (int i = gtid; i < NME; i += NGT) {
        const int k2 = i % (S5K / 2), no = (i / (S5K / 2)) % S5N, g = i / ((S5K / 2) * S5N);
        const int t = no >> 4, c = no & 15; float v[2];
#pragma unroll
        for (int e = 0; e < 2; ++e) {
            const int k = k2 * 2 + e; float val = 0.f;
            if (k < 512) { const int s = k >> 4, cp = k & 15;
                if (s <= t) val += KT[((0 * 32 + g) * 32 + (t - s)) * 256 + c * 16 + cp];
                if (s >= t) val += KT[((1 * 32 + g) * 32 + (s - t)) * 256 + c * 16 + cp];
                if (s == t && c == cp) val += dsk[g * 16 + c];
            } else { const int d = (k >= 640) ? 1 : 0, j = k - 512 - 128 * d, n = j & 63, im = j >> 6, pw = d ? (32 - t) : (t + 1), dg = d * 32 + g;
                const float cr = Cre[dg * 1024 + c * 64 + n], ci = Cim[dg * 1024 + c * 64 + n];
                const float pr = APOW[((size_t)dg * 33 + pw) * 128 + n * 2], pi = APOW[((size_t)dg * 33 + pw) * 128 + n * 2 + 1];
                val = im ? -(cr * pi + ci * pr) : (cr * pr - ci * pi); }
            v[e] = val;
        }
        *(unsigned*)(ME + ((size_t)g * S5N + no) * S5K + k2 * 2) = cvtpk(v[0], v[1]);
    }
    const int NBM = 32 * 256 * 256;
#pragma unroll 4
    for (int i = gtid; i < NBM; i += NGT) {
        const int k2 = i & 255, o = (i >> 8) & 255, g = i >> 16; float v[2];
        const int d = o >> 7, n = o & 63, im = (o >> 6) & 1, dg = d * 32 + g;
#pragma unroll
        for (int e = 0; e < 2; ++e) { const int k = k2 * 2 + e, s = k >> 4, cp = k & 15, pw = d ? s : (31 - s);
            const float pr = APOW[((size_t)dg * 33 + pw) * 128 + n * 2], pi = APOW[((size_t)dg * 33 + pw) * 128 + n * 2 + 1];
            const float br = BB[((size_t)dg * 64 + n) * 32 + cp * 2], bi = BB[((size_t)dg * 64 + n) * 32 + cp * 2 + 1];
            v[e] = im ? (pr * bi + pi * br) : (pr * br - pi * bi); }
        *(unsigned*)(BM + ((size_t)g * 256 + o) * 512 + k2 * 2) = cvtpk(v[0], v[1]);
    }
}
DI void s5_chain(const KP& P, int g) {
    const int tid = threadIdx.x;
    if (tid >= 128) return;
    const int d = tid >> 6, n = tid & 63, dg = d * 32 + g;
    const float* APOW = (const float*)(P.ws + M_APOW);
    const float ar = APOW[((size_t)dg * 33 + 32) * 128 + n * 2], ai = APOW[((size_t)dg * 33 + 32) * 128 + n * 2 + 1];
    const float* SS = (const float*)(P.ws + R_E) + (size_t)g * S5M * 256 + d * 128 + n;
    bf16_t* U = (bf16_t*)(P.ws + R_C) + (size_t)g * S5MP * S5K + 512 + d * 128 + n;
    float hr = 0.f, hi_ = 0.f;
    for (int i0 = 0; i0 < S5M; i0 += 40) {
        float sr[40], si[40]; int mm[40];
#pragma unroll
        for (int e = 0; e < 40; ++e) { const int i = i0 + e;
            const int m = d == 0 ? (i < 8 ? 512 + i : i - 8) : (i < 8 ? 519 - i : 519 - i);
            mm[e] = m; sr[e] = SS[(size_t)m * 256]; si[e] = SS[(size_t)m * 256 + 64]; }
#pragma unroll
        for (int e = 0; e < 40; ++e) {
            U[(size_t)mm[e] * S5K] = f2bf(hr); U[(size_t)mm[e] * S5K + 64] = f2bf(hi_);
            const float nr = ar * hr - ai * hi_ + sr[e], ni = ar * hi_ + ai * hr + si[e]; hr = nr; hi_ = ni; }
    }
}

DI bf16x8 frag_plain(const unsigned char* base, int RS, int row0, int k0, int r32, int hi) { return *(const bf16x8*)(base + (row0 + r32) * RS + (k0 + 8 * hi) * 2); }
DI bf16x8 frag_tr(const unsigned char* base, int RS, int k0, int col0, int lane) {
    const int hi = lane >> 5, q = (lane & 15) >> 2, p4 = lane & 3, cb = (lane >> 4) & 1;
    const int addr = (int)(uintptr_t)base + (k0 + 8 * hi + q) * RS + (col0 + 16 * cb + 4 * p4) * 2;
    s16x4 lo, hh;
    asm volatile("ds_read_b64_tr_b16 %0, %1" : "=&v"(lo) : "v"(addr) : "memory");
    asm volatile("ds_read_b64_tr_b16 %0, %1" : "=&v"(hh) : "v"(addr + 4 * RS) : "memory");
    asm volatile("s_waitcnt lgkmcnt(0)" ::: "memory"); __builtin_amdgcn_sched_barrier(0);
    return (bf16x8){lo[0], lo[1], lo[2], lo[3], hh[0], hh[1], hh[2], hh[3]};
}
DI void frag_tr_issue(const unsigned char* base, int RS, int k0, int col0, int lane, s16x4& lo, s16x4& hh) {
    const int hi = lane >> 5, q = (lane & 15) >> 2, p4 = lane & 3, cb = (lane >> 4) & 1;
    const int addr = (int)(uintptr_t)base + (k0 + 8 * hi + q) * RS + (col0 + 16 * cb + 4 * p4) * 2;
    asm volatile("ds_read_b64_tr_b16 %0, %1" : "=&v"(lo) : "v"(addr) : "memory");
    asm volatile("ds_read_b64_tr_b16 %0, %1" : "=&v"(hh) : "v"(addr + 4 * RS) : "memory");
}
#define TRPK(Lq, Hq) (bf16x8){Lq[0], Lq[1], Lq[2], Lq[3], Hq[0], Hq[1], Hq[2], Hq[3]}
constexpr int SA_XS = 0, SA_BS = 18432, SA_CS = 53248, SA_WS = 88064, SA_XW = 122880, SA_FL = 141312;
constexpr int RS64 = 144, RS128 = 272;

template <int NR> DI void conv_strip(const bf16_t* XBC, const float* cw, const float* cbias, int ch, int r0, int s0, int seq_lo, int seq_hi, unsigned char* dst, int rs, int coff) {
    float w[5][8], bias[8];
#pragma unroll
    for (int e = 0; e < 8; ++e) bias[e] = cbias[ch + e];
#pragma unroll
    for (int j = 0; j < 5; ++j)
#pragma unroll
        for (int e = 0; e < 8; ++e) w[j][e] = cw[j * 1024 + ch + e];
    u32x4 raw[NR + 4];
#pragma unroll
    for (int i = 0; i < NR + 4; ++i) { const int row = r0 + s0 + i - 2;
        if (row >= seq_lo && row < seq_hi) raw[i] = *(const u32x4*)(XBC + (size_t)row * 1024 + ch); else raw[i] = (u32x4){0u, 0u, 0u, 0u}; }
#pragma unroll
    for (int o = 0; o < NR; ++o) {
        float a[8];
#pragma unroll
        for (int e = 0; e < 8; ++e) a[e] = bias[e];
#pragma unroll
        for (int j = 0; j < 5; ++j) { const unsigned wv[4] = {raw[o + j].x, raw[o + j].y, raw[o + j].z, raw[o + j].w};
#pragma unroll
            for (int e = 0; e < 4; ++e) { a[2 * e] += w[j][2 * e] * bflo(wv[e]); a[2 * e + 1] += w[j][2 * e + 1] * bfhi(wv[e]); } }
        u32x4 ov; ov.x = cvtpk(silu_f(a[0]), silu_f(a[1])); ov.y = cvtpk(silu_f(a[2]), silu_f(a[3])); ov.z = cvtpk(silu_f(a[4]), silu_f(a[5])); ov.w = cvtpk(silu_f(a[6]), silu_f(a[7]));
        *(u32x4*)(dst + (s0 + o) * rs + coff * 2) = ov;
    }
}
DI void ssd_a_unit(const KP& P, int c, int gi, int hh_lo, int hh_hi, unsigned char* lds) {
    const int tid = tid_l(), lane = tid & 63, wid = tid >> 6, r32 = lane & 31, hi = lane >> 5;
    const int r0 = c * SQ;
    const int seq_lo = c < 128 ? 0 : L, seq_hi = c < 128 ? L : T;
    const bf16_t* XBC = (const bf16_t*)(P.ws + R1_XBC);
    const float* cw = P.in[36]; const float* cbias = P.in[37];
    float* fl = (float*)(lds + SA_FL);
    float* dtf = fl, *dtb = fl + 128, *csf = fl + 256, *ecsb = fl + 384, *wf = fl + 512, *wb = fl + 640;
    { const int oc = tid & 31, strip = tid >> 5;
      const bool isB = oc < 16; const int o16 = oc & 15;
      conv_strip<4>(XBC, cw, cbias, (isB ? 512 : 768) + gi * 128 + o16 * 8, r0, strip * 8, seq_lo, seq_hi, lds + (isB ? SA_BS : SA_CS), RS128, o16 * 8);
      conv_strip<4>(XBC, cw, cbias, (isB ? 512 : 768) + gi * 128 + o16 * 8, r0, strip * 8 + 4, seq_lo, seq_hi, lds + (isB ? SA_BS : SA_CS), RS128, o16 * 8); }
    __syncthreads();
    const int tb = wid >> 1, sh = wid & 1, pb = wid & 1;
    f32x16 G[2];
#pragma unroll
    for (int j = 0; j < 2; ++j)
#pragma unroll
        for (int r = 0; r < 16; ++r) G[j][r] = 0.f;
    const bool need_y = c < 128;
    if (need_y)
#pragma unroll
    for (int kk = 0; kk < 8; ++kk) {
        const bf16x8 a = frag_plain(lds + SA_CS, RS128, tb * 32, kk * 16, r32, hi);
#pragma unroll
        for (int j = 0; j < 2; ++j) { const bf16x8 b = frag_plain(lds + SA_BS, RS128, sh * 64 + j * 32, kk * 16, r32, hi); G[j] = MFMA32(a, b, G[j]); }
    }
    if (hh_lo == 0) { bf16_t* CC = (bf16_t*)(P.ws + R1_CC);
        for (int idx = tid; idx < 128 * 16; idx += NTHREADS) { const int s = idx >> 4, o8 = idx & 15;
            *(u32x4*)(CC + (size_t)(r0 + s) * 256 + gi * 128 + o8 * 8) = *(const u32x4*)(lds + SA_CS + s * RS128 + o8 * 16); } }
    bf16_t* SSg = (bf16_t*)(P.ws + R1_SS);
    const int tid_h = tid;
    __syncthreads();
    constexpr int SA_W2 = SA_CS;
#pragma unroll 1
    for (int hh = hh_lo; hh < hh_hi; ++hh) {
        const int h = gi * 4 + hh;
        int tl = tid_h; asm volatile("" : "+v"(tl));
        const int tid = tl, lane = tl & 63, wid = __builtin_amdgcn_readfirstlane(tl >> 6), r32 = lane & 31, hi = lane >> 5, tb = wid >> 1, sh = wid & 1, pb = wid & 1;
        { const int oc = tl & 7, strip = tl >> 3;
          conv_strip<2>(XBC, cw, cbias, h * 64 + oc * 8, r0, strip * 2, seq_lo, seq_hi, lds + SA_XS, RS64, oc * 8); }
        if (wid < 2) {
            const int d = wid; const float av = -expf(P.in[39][d * 8 + h]), bias = P.in[38][d * 8 + h];
            const float* DTR = (const float*)(P.ws + M_DTR);
            const float t0 = softplus_f(DTR[(size_t)(r0 + 2 * lane) * 16 + d * 8 + h] + bias), t1 = softplus_f(DTR[(size_t)(r0 + 2 * lane + 1) * 16 + d * 8 + h] + bias);
            const float a0 = t0 * av, a1 = t1 * av;
            float inc = a0 + a1;
#pragma unroll
            for (int o = 1; o < 64; o <<= 1) { const float u = __shfl_up(inc, o); if (lane >= o) inc += u; }
            const float excl = inc - (a0 + a1);
            const float tot = __shfl(inc, 63);
            float* CS = (float*)(P.ws + M_CS);
            if (d == 0) { dtf[2 * lane] = t0; dtf[2 * lane + 1] = t1; const float c0 = excl + a0, c1 = excl + a0 + a1; csf[2 * lane] = c0; csf[2 * lane + 1] = c1;
                wf[2 * lane] = t0 * __expf(tot - c0); wf[2 * lane + 1] = t1 * __expf(tot - c1);
                CS[(size_t)(r0 + 2 * lane) * 16 + h] = c0; CS[(size_t)(r0 + 2 * lane + 1) * 16 + h] = c1;
            } else { dtb[2 * lane] = t0; dtb[2 * lane + 1] = t1; const float e0 = excl, e1 = excl + a0; ecsb[2 * lane] = e0; ecsb[2 * lane + 1] = e1;
                wb[2 * lane] = t0 * __expf(e0); wb[2 * lane + 1] = t1 * __expf(e1);
                CS[(size_t)(r0 + 2 * lane) * 16 + 8 + h] = tot - e0; CS[(size_t)(r0 + 2 * lane + 1) * 16 + 8 + h] = tot - e1; }
            if (lane == 0) ((float*)(P.ws + M_DEC))[(d * SNC + c) * 8 + h] = tot;
        }
        __syncthreads();
        if (need_y) {
#pragma unroll
        for (int j = 0; j < 2; ++j) { const int s_ = sh * 64 + j * 32 + r32;
            const float csf_s = csf[s_], ecs_s = ecsb[s_], dtf_s = dtf[s_], dtb_s = dtb[s_];
#pragma unroll
            for (int r = 0; r < 16; ++r) { const int t = tb * 32 + crow(r, hi); const float csf_t = csf[t], ecs_t = ecsb[t];
                const float arg = (s_ <= t) ? (csf_t - csf_s) : (ecs_s - ecs_t);
                const float dts = (s_ < t) ? dtf_s : ((s_ > t) ? dtb_s : dtf_s + dtb_s);
                *(bf16_t*)(lds + SA_WS + t * RS128 + s_ * 2) = f2bf(G[j][r] * __expf(arg) * dts);
                if ((r & 3) == 3) __builtin_amdgcn_sched_barrier(0); } }
        __syncthreads();
        { f32x16 Y;
#pragma unroll
          for (int r = 0; r < 16; ++r) Y[r] = 0.f;
#pragma unroll
          for (int k4 = 0; k4 < 2; ++k4) { s16x4 xl[4], xh[4];
#pragma unroll
              for (int q = 0; q < 4; ++q) frag_tr_issue(lds + SA_XS, RS64, (k4 * 4 + q) * 16, pb * 32, lane, xl[q], xh[q]);
              asm volatile("s_waitcnt lgkmcnt(0)" ::: "memory"); __builtin_amdgcn_sched_barrier(0);
#pragma unroll
              for (int q = 0; q < 4; ++q) { const int kk = k4 * 4 + q; const bf16x8 xb = TRPK(xl[q], xh[q]);
                  const bf16x8 a0 = frag_plain(lds + SA_WS, RS128, tb * 32, kk * 16, r32, hi);
                  Y = MFMA32(a0, xb, Y); } }
          const float dsk = P.in[40][h]; bf16_t* YP = (bf16_t*)(P.ws + R1_YP);
#pragma unroll
          for (int r = 0; r < 16; ++r) { const int t = tb * 32 + crow(r, hi), p = pb * 32 + r32;
              const float xv = bf2f(*(const bf16_t*)(lds + SA_XS + t * RS64 + p * 2));
              YP[(size_t)(r0 + t) * 512 + h * 64 + p] = f2bf(Y[r] + dsk * xv); } }
        __syncthreads();
        }
        for (int idx = tid; idx < 128 * 32; idx += NTHREADS) { const int s_ = idx >> 5, p2 = idx & 31;
            const unsigned v = *(const unsigned*)(lds + SA_XS + s_ * RS64 + p2 * 4); const float w0 = wf[s_], w1 = wb[s_];
            *(unsigned*)(lds + SA_WS + s_ * RS64 + p2 * 4) = cvtpk(bflo(v) * w0, bfhi(v) * w0);
            *(unsigned*)(lds + SA_W2 + s_ * RS64 + p2 * 4) = cvtpk(bflo(v) * w1, bfhi(v) * w1); }
        __syncthreads();
        { const int pbl = wid >> 2, nb = wid & 3;
          f32x16 S0, S1;
#pragma unroll
          for (int r = 0; r < 16; ++r) { S0[r] = 0.f; S1[r] = 0.f; }
#pragma unroll
          for (int k4 = 0; k4 < 4; ++k4) { s16x4 al[2], ah[2], cl[2], ch_[2], bl[2], bh[2];
#pragma unroll
              for (int q = 0; q < 2; ++q) { frag_tr_issue(lds + SA_WS, RS64, (k4 * 2 + q) * 16, pbl * 32, lane, al[q], ah[q]); frag_tr_issue(lds + SA_W2, RS64, (k4 * 2 + q) * 16, pbl * 32, lane, cl[q], ch_[q]);
                  frag_tr_issue(lds + SA_BS, RS128, (k4 * 2 + q) * 16, nb * 32, lane, bl[q], bh[q]); }
              asm volatile("s_waitcnt lgkmcnt(0)" ::: "memory"); __builtin_amdgcn_sched_barrier(0);
#pragma unroll
              for (int q = 0; q < 2; ++q) { const bf16x8 bb = TRPK(bl[q], bh[q]); S0 = MFMA32(TRPK(al[q], ah[q]), bb, S0); S1 = MFMA32(TRPK(cl[q], ch_[q]), bb, S1); } }
          bf16_t* d0p = SSg + ((size_t)(0 * SNC + c) * 8 + h) * 8192; bf16_t* d1p = SSg + ((size_t)(1 * SNC + c) * 8 + h) * 8192;
#pragma unroll
          for (int r = 0; r < 16; ++r) { const int o_ = (pbl * 32 + crow(r, hi)) * 128 + nb * 32 + r32; d0p[o_] = f2bf(S0[r]); d1p[o_] = f2bf(S1[r]); } }
        __syncthreads();
    }
}

DI void ssd_chain(const KP& P, int blk, unsigned char* lds) {
    const int tid = tid_l();
    const int gtid0 = blk * 256, d = gtid0 >> 15, rem0 = gtid0 & 32767, h = rem0 >> 12;
    float* dkl = (float*)(lds + 143360);
    if (tid < SNC) { const int i = tid; const int c = d == 0 ? (i < 2 ? 128 + i : i - 2) : (129 - i);
        dkl[i] = __expf(((const float*)(P.ws + M_DEC))[(d * SNC + c) * 8 + h]); }
    __syncthreads();
    if (tid < 256) {
        unsigned* SSg = (unsigned*)(P.ws + R1_SS) + (size_t)d * SNC * 32768 + rem0 + tid;
        float s0 = 0.f, s1 = 0.f;
#pragma unroll 1
        for (int i0 = 0; i0 < SNC; i0 += 65) {
            unsigned v[65];
#pragma unroll
            for (int e = 0; e < 65; ++e) { const int i = i0 + e; const int c = d == 0 ? (i < 2 ? 128 + i : i - 2) : (129 - i); v[e] = SSg[(size_t)c * 32768]; }
#pragma unroll
            for (int e = 0; e < 65; ++e) { const int i = i0 + e; const int c = d == 0 ? (i < 2 ? 128 + i : i - 2) : (129 - i);
                SSg[(size_t)c * 32768] = cvtpk(s0, s1);
                const float dk = dkl[i]; s0 = dk * s0 + bflo(v[e]); s1 = dk * s1 + bfhi(v[e]); }
        }
    }
    __syncthreads();
}

constexpr int SC_CS = 0, SC_HS = 34816, SC_RED = 104448;
DI void ssd_c_unit(const KP& P, int c, int gi, unsigned char* lds) {
    const int tid = tid_l(), lane = tid & 63, wid = tid >> 6, r32 = lane & 31, hi = lane >> 5;
    const int r0 = c * SQ, tb = wid >> 1, half = wid & 1;
    const bf16_t* CC = (const bf16_t*)(P.ws + R1_CC);
    const bf16_t* SSg = (const bf16_t*)(P.ws + R1_SS);
    const float* CS = (const float*)(P.ws + M_CS);
    for (int idx = tid; idx < 128 * 16; idx += NTHREADS) { const int s = idx >> 4, o8 = idx & 15;
        *(u32x4*)(lds + SC_CS + s * RS128 + o8 * 16) = *(const u32x4*)(CC + (size_t)(r0 + s) * 256 + gi * 128 + o8 * 8); }
    f32x16 tot[4];
#pragma unroll
    for (int j = 0; j < 4; ++j)
#pragma unroll
        for (int r = 0; r < 16; ++r) tot[j][r] = 0.f;
#pragma unroll 1
    for (int d = 0; d < 2; ++d) {
        const bf16_t* src = SSg + ((size_t)(d * SNC + c) * 8 + gi * 4) * 8192;
        for (int idx = tid; idx < 256 * 16; idx += NTHREADS) { const int row = idx >> 4, o8 = idx & 15;
            *(u32x4*)(lds + SC_HS + row * RS128 + o8 * 16) = *(const u32x4*)(src + (size_t)row * 128 + o8 * 8); }
        __syncthreads();
        f32x16 acc[4];
#pragma unroll
        for (int j = 0; j < 4; ++j)
#pragma unroll
            for (int r = 0; r < 16; ++r) acc[j][r] = 0.f;
#pragma unroll
        for (int kk = 0; kk < 8; ++kk) {
            const bf16x8 a = frag_plain(lds + SC_CS, RS128, tb * 32, kk * 16, r32, hi);
#pragma unroll
            for (int j = 0; j < 4; ++j) { const bf16x8 b = frag_plain(lds + SC_HS, RS128, half * 128 + j * 32, kk * 16, r32, hi); acc[j] = MFMA32(a, b, acc[j]); }
        }
#pragma unroll
        for (int r = 0; r < 16; ++r) { const int t = tb * 32 + crow(r, hi);
#pragma unroll
            for (int j = 0; j < 4; ++j) { const int hh = half * 2 + (j >> 1); const float e = __expf(CS[(size_t)(r0 + t) * 16 + d * 8 + gi * 4 + hh]); tot[j][r] += e * acc[j][r]; } }
        __syncthreads();
    }
    const bf16_t* YP = (const bf16_t*)(P.ws + R1_YP); const bf16_t* Z = (const bf16_t*)(P.ws + R1_Z);
    float* red = (float*)(lds + SC_RED);
#pragma unroll
    for (int r = 0; r < 16; ++r) { const int t = tb * 32 + crow(r, hi); float ss = 0.f;
#pragma unroll
        for (int j = 0; j < 4; ++j) { const int colg = half * 128 + j * 32 + r32; const size_t gidx = (size_t)(r0 + t) * 512 + gi * 256 + colg;
            const float y = tot[j][r] + bf2f(YP[gidx]); const float gy = y * silu_f(bf2f(Z[gidx])); tot[j][r] = gy; ss += gy * gy; }
#pragma unroll
        for (int s = 1; s < 32; s <<= 1) ss += __shfl_xor(ss, s);
        if (r32 == 0) red[t * 2 + half] = ss; }
    __syncthreads();
    bf16_t* CAT = (bf16_t*)(P.ws + R_H); const float* gs = P.in[41];
#pragma unroll
    for (int r = 0; r < 16; ++r) { const int t = tb * 32 + crow(r, hi); const float rstd = rsqrtf((red[t * 2] + red[t * 2 + 1]) * (1.f / 256.f) + EPS);
#pragma unroll
        for (int j = 0; j < 4; ++j) { const int colg = half * 128 + j * 32 + r32;
            CAT[(size_t)(r0 + t) * 1024 + 512 + gi * 256 + colg] = f2bf(tot[j][r] * rstd * gs[gi * 256 + colg]); } }
    __syncthreads();
}

namespace pg8 {
#define PG8_LAS __attribute__((address_space(3)))
typedef unsigned short bf16_t;
typedef short bf16x8 __attribute__((ext_vector_type(8)));
typedef float f32x4 __attribute__((ext_vector_type(4)));
typedef unsigned u32x4 __attribute__((ext_vector_type(4)));
constexpr int BM = 256, BK = 64, HALF = 128, HTB = HALF * BK * 2  , STAGE_BYTES = 8 * HTB, NXCD = 8, WGM = 8;

__host__ __device__ __forceinline__ int lds_byte(int r, int c) { const int st = (r >> 4) * 2 + (c >> 5), rr = r & 15, cc = c & 31, ob = rr * 64 + cc * 2; return st * 1024 + (ob ^ (((ob >> 9) & 1) << 5)); }
__host__ __device__ __forceinline__ void stage_rc(int b, int& R, int& C) { const int st = b / 1024, sb = b % 1024, swz = sb ^ (((sb >> 9) & 1) << 5); R = (st >> 1) * 16 + swz / 64; C = (st & 1) * 32 + (swz % 64) / 2; }
__host__ __device__ __forceinline__ int perm32(int rho) { const int n = rho >> 4, i = rho & 15; return 8 * (i >> 2) + 4 * n + (i & 3); }

struct Unit { int pm, pn; };
struct Gemm { const bf16_t* A; const bf16_t* Bt; int M, N, K; int bdiv = 0, nNb = 1; };

struct StaticOrder {
    int nM, nN, nwg, G, c;
    __host__ __device__ void init(int M, int N, int G_, int c_) { nM = M / BM; nN = N / BM; nwg = nM * nN; G = G_; c = c_; }
    __host__ __device__ bool next(int i, Unit& u) const {
        const long L = (long)i * G + c; if (L >= nwg) return false;
        int wgid = (int)L; { const int q = nwg / NXCD, r = nwg % NXCD, xcd = wgid % NXCD, off = wgid / NXCD; wgid = (xcd < r ? xcd * (q + 1) : r * (q + 1) + (xcd - r) * q) + off; }
        const int nig = WGM * nN, gid = wgid / nig, fm = gid * WGM, gsz = (nM - fm) < WGM ? (nM - fm) : WGM;
        u.pm = fm + ((wgid % nig) % gsz); u.pn = (wgid % nig) / gsz; return true;
    }
    __device__ __forceinline__ void a_ready(const Unit&) const {}
    __device__ __forceinline__ void done(const Unit&) const {}
};

typedef unsigned u32x2p __attribute__((ext_vector_type(2)));
__device__ __forceinline__ u32x2p pk4(f32x4 v) { u32x2p w; w.x = ::cvtpk(v[0], v[1]); w.y = ::cvtpk(v[2], v[3]); return w; }
template <int EPI> struct EpiT {
    static constexpr bool PERM = false, AFTER_DRAIN = false;
    const ::KP& P;
    __device__ __forceinline__ void st4(int row, int c, f32x4 v) const {
        unsigned char* ws = P.ws;
        if constexpr (EPI == ::EPI_G1) {
            if (c < 672) *(u32x2p*)((::bf16_t*)(ws + ::R_B) + (size_t)row * 672 + c) = pk4(v);
            else if (c < 1184) { const int cc = c - 672, g = cc >> 4, ch = cc & 15, m_ = row >> 5, s_ = row & 31;
                *(u32x2p*)((::bf16_t*)(ws + ::R_C) + ((size_t)g * ::S5MP + m_) * ::S5K + s_ * 16 + ch) = pk4(v); }
        } else if constexpr (EPI == ::EPI_RES_A0) { const float* mods = (const float*)(ws + ::M_MODS);
            if (row < ::L) { const f32x4 xin = *(const f32x4*)(P.in[0] + (size_t)row * 1024 + c), gg = *(const f32x4*)(mods + 2048 + c); *(f32x4*)(P.out + (size_t)row * 1024 + c) = xin + gg * v; }
            else { const f32x4 xin = *(const f32x4*)(P.in[2] + (size_t)(row - ::L) * 1024 + c), gg = *(const f32x4*)(mods + 6144 + 2048 + c); *(f32x4*)((float*)(ws + ::M_XC) + (size_t)(row - ::L) * 1024 + c) = xin + gg * v; }
        } else if constexpr (EPI == ::EPI_RES_F0) { const float* mods = (const float*)(ws + ::M_MODS);
            if (row < ::L) { f32x4* p = (f32x4*)(P.out + (size_t)row * 1024 + c); const f32x4 gg = *(const f32x4*)(mods + 5120 + c); *p = *p + gg * v; }
            else { f32x4* p = (f32x4*)((float*)(ws + ::M_XC) + (size_t)(row - ::L) * 1024 + c); const f32x4 gg = *(const f32x4*)(mods + 6144 + 5120 + c); *p = *p + gg * v; }
        } else if constexpr (EPI == ::EPI_G8) {
            if (c < 1024) *(u32x2p*)((::bf16_t*)(ws + ::R1_QK) + (size_t)row * 1024 + c) = pk4(v);
            else if (c < 1536) *(u32x2p*)((::bf16_t*)(ws + ::R1_V) + (size_t)row * 512 + c - 1024) = pk4(v);
            else if (c < 2048) *(u32x2p*)((::bf16_t*)(ws + ::R1_Z) + (size_t)row * 512 + c - 1536) = pk4(v);
            else if (c < 3072) *(u32x2p*)((::bf16_t*)(ws + ::R1_XBC) + (size_t)row * 1024 + c - 2048) = pk4(v);
            else if (c < 3088) *(f32x4*)((float*)(ws + ::M_DTR) + (size_t)row * 16 + c - 3072) = v;
        } else if constexpr (EPI == ::EPI_S5S) { const int b_ = row / ::S5MP, m_ = row - b_ * ::S5MP;
            if (m_ < ::S5M) *(f32x4*)((float*)(ws + ::R_E) + ((size_t)b_ * ::S5M + m_) * 256 + c) = v;
        } else if constexpr (EPI == ::EPI_S5Y) { const int b_ = row / ::S5MP, m_ = row - b_ * ::S5MP;
            if (m_ < ::S5M) { const int t_ = c >> 4, ch = c & 15; f32x4 gv; gv[0] = ::gelu_tanh(v[0]); gv[1] = ::gelu_tanh(v[1]); gv[2] = ::gelu_tanh(v[2]); gv[3] = ::gelu_tanh(v[3]);
                *(u32x2p*)((::bf16_t*)((unsigned char*)P.out + ::O_GG) + ((size_t)m_ * 32 + t_) * 512 + b_ * 16 + ch) = pk4(gv); }
        } else if constexpr (EPI == ::EPI_GLU) {
            const u32x2p gw_ = *(const u32x2p*)((const ::bf16_t*)((const unsigned char*)P.out + ::O_GG) + (size_t)row * 512 + c); const f32x4 bb = *(const f32x4*)(P.in[26] + c);
            f32x4 o_; o_[0] = ::bflo(gw_.x) * ::sigmoid_f(v[0] + bb[0]); o_[1] = ::bfhi(gw_.x) * ::sigmoid_f(v[1] + bb[1]); o_[2] = ::bflo(gw_.y) * ::sigmoid_f(v[2] + bb[2]); o_[3] = ::bfhi(gw_.y) * ::sigmoid_f(v[3] + bb[3]);
            *(u32x2p*)((::bf16_t*)(ws + ::R_H) + (size_t)row * 1024 + 512 + c) = pk4(o_);
        } else if constexpr (EPI == ::EPI_RES_A1) { const float* mods = (const float*)(ws + ::M_MODS);
            f32x4* p = (f32x4*)(P.out + (size_t)row * 1024 + c); const f32x4 gg = *(const f32x4*)(mods + 2 * 6144 + 2048 + c); *p = *p + gg * v;
        } else if constexpr (EPI == ::EPI_RES_F1) { const float* mods = (const float*)(ws + ::M_MODS);
            f32x4* p = (f32x4*)(P.out + (size_t)row * 1024 + c); const f32x4 gg = *(const f32x4*)(mods + 2 * 6144 + 5120 + c); *p = *p + gg * v;
        }
    }
    __device__ __forceinline__ void operator()(const f32x4 (&acc)[2][2][4][2], const Unit& u, int wr, int wc, int fr, int fq) const {
        if constexpr (EPI == ::EPI_RES_A0 || EPI == ::EPI_RES_F0 || EPI == ::EPI_RES_A1 || EPI == ::EPI_RES_F1) {
            const float* mods = (const float*)(P.ws + ::M_MODS);
            const bool isctx = (EPI == ::EPI_RES_A0 || EPI == ::EPI_RES_F0) && u.pm * BM >= ::L;
            const int goff = (EPI == ::EPI_RES_A0 ? 2048 : EPI == ::EPI_RES_F0 ? 5120 : EPI == ::EPI_RES_A1 ? 2 * 6144 + 2048 : 2 * 6144 + 5120) + (isctx ? 6144 : 0);
            float* dst = isctx ? (float*)(P.ws + ::M_XC) : P.out;
            const float* src = EPI == ::EPI_RES_A0 ? (isctx ? P.in[2] : P.in[0]) : dst;
            const int rbase = u.pm * BM - (isctx ? ::L : 0) + wr * 64 + fr, cbase = u.pn * BM + wc * 32 + 4 * fq;
#pragma unroll
            for (int ai = 0; ai < 2; ++ai)
#pragma unroll
                for (int bj = 0; bj < 2; ++bj) {
                    f32x4 xin[4][2], gg[2];
#pragma unroll
                    for (int n = 0; n < 2; ++n) gg[n] = *(const f32x4*)(mods + goff + cbase + bj * HALF + n * 16);
#pragma unroll
                    for (int m = 0; m < 4; ++m)
#pragma unroll
                        for (int n = 0; n < 2; ++n) xin[m][n] = *(const f32x4*)(src + (size_t)(rbase + ai * HALF + m * 16) * 1024 + cbase + bj * HALF + n * 16);
#pragma unroll
                    for (int m = 0; m < 4; ++m)
#pragma unroll
                        for (int n = 0; n < 2; ++n) *(f32x4*)(dst + (size_t)(rbase + ai * HALF + m * 16) * 1024 + cbase + bj * HALF + n * 16) = xin[m][n] + gg[n] * acc[ai][bj][m][n];
                }
            return;
        }
#pragma unroll
        for (int ai = 0; ai < 2; ++ai)
#pragma unroll
            for (int m = 0; m < 4; ++m) { const int row = u.pm * BM + ai * HALF + wr * 64 + m * 16 + fr;
#pragma unroll
                for (int n = 0; n < 2; ++n) { const int cl = wc * 32 + n * 16 + 4 * fq, c0 = u.pn * BM + cl;
                    if constexpr (EPI == ::EPI_SWIGLU) { const f32x4 a = acc[ai][0][m][n], b = acc[ai][1][m][n]; f32x4 h;
#pragma unroll
                        for (int e = 0; e < 4; ++e) h[e] = ::silu_f(a[e]) * b[e];
                        *(u32x2p*)((::bf16_t*)(P.ws + ::R_HFF) + (size_t)row * ::DFF + u.pn * HALF + cl) = pk4(h);
                    } else { st4(row, c0, acc[ai][0][m][n]); st4(row, c0 + HALF, acc[ai][1][m][n]); } } }
    }
};

template <class Epi, class Sched, bool ALIGN_EPI = false, bool SP2 = false, int LDA_C = 0>
__device__ __forceinline__ void gemm_phase(PG8_LAS unsigned char* lds, const Gemm g, const Sched& S, const Epi& E) {
    const int tid = threadIdx.x, wid = __builtin_amdgcn_readfirstlane(tid >> 6), lane = tid & 63, wr = wid >> 2, wc = wid & 3, fr = lane & 15, fq = lane >> 4;
    const int K = g.K, nt = K / BK; const int LDA = LDA_C ? LDA_C : g.K;
    unsigned voffA[2], voffB[2];
#pragma unroll
    for (int i = 0; i < 2; ++i) { int R, C; stage_rc(tid * 16 + i * 8192, R, C); const int Rb = Epi::PERM ? ((R & ~31) + perm32(R & 31)) : R;
        voffA[i] = (unsigned)(R * LDA + C) * 2u; voffB[i] = (unsigned)(Rb * K + C) * 2u; }
    const size_t kstep = (size_t)(BK * 2);
    const size_t hstep = (size_t)HALF * K * 2, hstepA = (size_t)HALF * LDA * 2;
    const size_t tstep = 2 * hstep, tstepA = 2 * hstepA;
    const unsigned ldsw = (unsigned)wid * 1024u;
    const int aoff = lds_byte(wr * 64 + fr, fq * 8), boff = lds_byte(wc * 32 + fr, fq * 8);
#define PG8_SA(b, h) (((b) * 2 + (h)) * HTB)
#define PG8_SB(b, h) ((4 + (b) * 2 + (h)) * HTB)
#define PG8_STAGE(bufoff, gbase, voff) do { _Pragma("unroll") for (int _i = 0; _i < 2; ++_i) \
        __builtin_amdgcn_global_load_lds((const unsigned*)((const char*)(gbase) + (voff)[_i]), (PG8_LAS unsigned*)(lds + (bufoff) + ldsw + _i * 8192), 16, 0, 0); } while (0)
#define PG8_LDA(dst, b, h) do { _Pragma("unroll") for (int m = 0; m < 4; ++m) _Pragma("unroll") for (int k = 0; k < 2; ++k) dst[m][k] = *(const PG8_LAS bf16x8*)(lds + PG8_SA(b, h) + aoff + m * 2048 + k * 1024); } while (0)
#define PG8_LDB(dst, b, h) do { _Pragma("unroll") for (int n = 0; n < 2; ++n) _Pragma("unroll") for (int k = 0; k < 2; ++k) dst[n][k] = *(const PG8_LAS bf16x8*)(lds + PG8_SB(b, h) + boff + n * 2048 + k * 1024); } while (0)
#define PG8_MMA(ai, bj, At, Bt) do { __builtin_amdgcn_s_setprio(1); _Pragma("unroll") for (int m = 0; m < 4; ++m) _Pragma("unroll") for (int n = 0; n < 2; ++n) _Pragma("unroll") for (int k = 0; k < 2; ++k) \
        acc[ai][bj][m][n] = __builtin_amdgcn_mfma_f32_16x16x32_bf16(Bt[n][k], At[m][k], acc[ai][bj][m][n], 0, 0, 0); __builtin_amdgcn_s_setprio(0); } while (0)
#define PG8_WAIT_V(n) asm volatile("s_waitcnt vmcnt(" #n ")" ::: "memory")
#define PG8_WAIT_L(n) asm volatile("s_waitcnt lgkmcnt(" #n ")" ::: "memory")
#define PG8_BAR __builtin_amdgcn_s_barrier()
#define PG8_SCHED __builtin_amdgcn_sched_barrier(0)
    Unit cur, nxt; int ui = 0;
    if (!S.next(0, cur)) return;
    f32x4 acc[2][2][4][2];
#pragma unroll
    for (int a = 0; a < 2; ++a)
#pragma unroll
        for (int b = 0; b < 2; ++b)
#pragma unroll
            for (int m = 0; m < 4; ++m)
#pragma unroll
                for (int n = 0; n < 2; ++n) acc[a][b][m][n] = (f32x4){0.f, 0.f, 0.f, 0.f};
    bf16x8 At[4][2], B0[2][2], B1[2][2];
    const char* cA = (const char*)g.A + (size_t)cur.pm * tstepA; const char* cB = (const char*)g.Bt + (size_t)(g.bdiv ? (cur.pm / g.bdiv) * g.nNb + cur.pn : cur.pn) * tstep;
    S.a_ready(cur);
    if constexpr (SP2) {
        PG8_STAGE(PG8_SB(0, 0), cB, voffB); PG8_STAGE(PG8_SB(0, 1), cB + hstep, voffB); PG8_STAGE(PG8_SA(0, 0), cA, voffA); PG8_STAGE(PG8_SA(0, 1), cA + hstepA, voffA);
        if (wr == 1) PG8_BAR;
        PG8_WAIT_V(2); PG8_BAR;
        PG8_STAGE(PG8_SB(1, 0), cB + kstep, voffB); PG8_STAGE(PG8_SA(1, 0), cA + kstep, voffA); PG8_STAGE(PG8_SB(1, 1), cB + hstep + kstep, voffB);
        PG8_WAIT_V(6); PG8_BAR;
    } else {
        PG8_STAGE(PG8_SB(0, 0), cB, voffB); PG8_STAGE(PG8_SA(0, 0), cA, voffA); PG8_STAGE(PG8_SB(0, 1), cB + hstep, voffB); PG8_STAGE(PG8_SA(0, 1), cA + hstepA, voffA);
        if (wr == 1) PG8_BAR;
        PG8_WAIT_V(4); PG8_BAR;
        PG8_STAGE(PG8_SB(1, 0), cB + kstep, voffB); PG8_STAGE(PG8_SA(1, 0), cA + kstep, voffA); PG8_STAGE(PG8_SB(1, 1), cB + hstep + kstep, voffB);
        PG8_WAIT_V(6); PG8_BAR;
    }
    for (;;) {
        const bool has_next = S.next(ui + 1, nxt);
        const char* nA = has_next ? (const char*)g.A + (size_t)nxt.pm * tstepA : cA; const char* nB = has_next ? (const char*)g.Bt + (size_t)(g.bdiv ? (nxt.pm / g.bdiv) * g.nNb + nxt.pn : nxt.pn) * tstep : cB;
#pragma unroll 1
        for (int t = 0; t < nt; t += 2) {
            const bool last = (t == nt - 2);
            const char* a1 = cA + (size_t)(t + 1) * kstep;
            const char* a2 = last ? nA : cA + (size_t)(t + 2) * kstep; const char* b2 = last ? nB : cB + (size_t)(t + 2) * kstep;
            const char* a3 = a2 + kstep; const char* b3 = b2 + kstep;
            if (last && has_next) S.a_ready(nxt);
            if constexpr (SP2) {
            PG8_LDB(B0, 0, 0); PG8_LDB(B1, 0, 1); PG8_SCHED; PG8_LDA(At, 0, 0); PG8_STAGE(PG8_SA(1, 1), a1 + hstepA, voffA);
            PG8_WAIT_V(8); PG8_WAIT_L(0); PG8_BAR; PG8_MMA(0, 0, At, B0); PG8_MMA(0, 1, At, B1); PG8_BAR; PG8_SCHED;
            PG8_LDA(At, 0, 1); PG8_STAGE(PG8_SB(0, 0), b2, voffB); PG8_STAGE(PG8_SB(0, 1), b2 + hstep, voffB); PG8_STAGE(PG8_SA(0, 0), a2, voffA);
            PG8_WAIT_V(8); PG8_WAIT_L(0); PG8_BAR; PG8_MMA(1, 0, At, B0); PG8_MMA(1, 1, At, B1); PG8_BAR; PG8_SCHED;
            PG8_LDB(B0, 1, 0); PG8_LDB(B1, 1, 1); PG8_SCHED; PG8_LDA(At, 1, 0); PG8_STAGE(PG8_SA(0, 1), a2 + hstepA, voffA);
            PG8_WAIT_V(8); PG8_WAIT_L(0); PG8_BAR; PG8_MMA(0, 0, At, B0); PG8_MMA(0, 1, At, B1); PG8_BAR; PG8_SCHED;
            PG8_LDA(At, 1, 1); PG8_STAGE(PG8_SB(1, 0), b3, voffB); PG8_STAGE(PG8_SB(1, 1), b3 + hstep, voffB); PG8_STAGE(PG8_SA(1, 0), a3, voffA);
            PG8_WAIT_V(8); PG8_WAIT_L(0); PG8_BAR; PG8_MMA(1, 0, At, B0); PG8_MMA(1, 1, At, B1); PG8_BAR; PG8_SCHED;
            } else {
            PG8_LDB(B0, 0, 0); PG8_SCHED; PG8_LDA(At, 0, 0); PG8_STAGE(PG8_SA(1, 1), a1 + hstepA, voffA);
            PG8_WAIT_L(8); PG8_BAR; PG8_WAIT_L(0); PG8_MMA(0, 0, At, B0); PG8_BAR; PG8_SCHED;
            PG8_LDB(B1, 0, 1); PG8_STAGE(PG8_SB(0, 0), b2, voffB);
            PG8_BAR; PG8_WAIT_L(0); PG8_MMA(0, 1, At, B1); PG8_BAR;
            PG8_LDA(At, 0, 1); PG8_STAGE(PG8_SA(0, 0), a2, voffA);
            PG8_BAR; PG8_WAIT_L(0); PG8_MMA(1, 0, At, B0); PG8_BAR; PG8_SCHED;
            PG8_STAGE(PG8_SB(0, 1), b2 + hstep, voffB);
            PG8_WAIT_V(6); PG8_BAR; PG8_MMA(1, 1, At, B1); PG8_BAR;
            PG8_LDB(B0, 1, 0); PG8_SCHED; PG8_LDA(At, 1, 0); PG8_STAGE(PG8_SA(0, 1), a2 + hstepA, voffA);
            PG8_WAIT_L(8); PG8_BAR; PG8_WAIT_L(0); PG8_MMA(0, 0, At, B0); PG8_BAR; PG8_SCHED;
            PG8_LDB(B1, 1, 1); PG8_STAGE(PG8_SB(1, 0), b3, voffB);
            PG8_BAR; PG8_WAIT_L(0); PG8_MMA(0, 1, At, B1); PG8_BAR;
            PG8_LDA(At, 1, 1); PG8_STAGE(PG8_SA(1, 0), a3, voffA);
            PG8_BAR; PG8_WAIT_L(0); PG8_MMA(1, 0, At, B0); PG8_BAR; PG8_SCHED;
            PG8_STAGE(PG8_SB(1, 1), b3 + hstep, voffB);
            PG8_WAIT_V(6); PG8_BAR; PG8_MMA(1, 1, At, B1); PG8_BAR;
            }
        }
        if constexpr (ALIGN_EPI) { if (wr == 0) PG8_BAR; }
        if constexpr (!Epi::AFTER_DRAIN) { E(acc, cur, wr, wc, fr, fq); S.done(cur); }
        if (!has_next) break;
#pragma unroll
        for (int a = 0; a < 2; ++a)
#pragma unroll
            for (int b = 0; b < 2; ++b)
#pragma unroll
                for (int m = 0; m < 4; ++m)
#pragma unroll
                    for (int n = 0; n < 2; ++n) acc[a][b][m][n] = (f32x4){0.f, 0.f, 0.f, 0.f};
        cur = nxt; cA = nA; cB = nB; ++ui;
        if constexpr (ALIGN_EPI) { if (wr == 1) PG8_BAR; }
    }
    PG8_WAIT_V(0);
    if constexpr (!ALIGN_EPI) { if (wr == 0) PG8_BAR; }
    PG8_BAR;
    if constexpr (Epi::AFTER_DRAIN) { E.fused(acc, cur, wr, wc, fr, fq, lds, wid, lane); S.done(cur); }
#undef PG8_SA
#undef PG8_SB
#undef PG8_STAGE
#undef PG8_LDA
#undef PG8_LDB
#undef PG8_MMA
#undef PG8_WAIT_V
#undef PG8_WAIT_L
#undef PG8_BAR
#undef PG8_SCHED
}
}

#define XB_TMO      128
#define XB_XCNT(j)  (256  + 64 * (j))
#define XB_XSUB(j)  (1280 + 64 * (j))
#define XB_XGEN(j)  (2304 + 64 * (j))
#define XB_TOP      3328
#define XB_TOPGEN   3392
#define XCD_BAR_WORDS 3456
#define XB_SPIN_CAP (1u << 20)
#define LAS __attribute__((address_space(3)))
DI unsigned xb_ld(unsigned* p)              { return __hip_atomic_load(p, __ATOMIC_RELAXED, __HIP_MEMORY_SCOPE_AGENT); }
DI unsigned xb_add(unsigned* p, unsigned v) { return __hip_atomic_fetch_add(p, v, __ATOMIC_RELAXED, __HIP_MEMORY_SCOPE_AGENT); }
DI unsigned xb_xcc_id() { return (unsigned)__builtin_amdgcn_s_getreg((3 << 11) | 20) & 0xFu; }
#define XB_SPIN(cond, bar) do { unsigned _sp = 0; while (cond) { __builtin_amdgcn_s_sleep(3); \
    if ((++_sp & 255u) == 0u) { if (xb_ld(&(bar)[XB_TMO])) break; if (_sp > XB_SPIN_CAP) { atomicAdd(&(bar)[XB_TMO], 1u); break; } } } } while (0)
struct XcdBarrier { unsigned* bar; unsigned x; volatile LAS unsigned* st; };
DI XcdBarrier xcd_barrier_post(unsigned* bar, volatile LAS unsigned* st) {
    XcdBarrier b; b.bar = bar; b.x = xb_xcc_id(); b.st = st;
    if (threadIdx.x == 0) (void)xb_add(&bar[XB_XCNT(b.x)], 1u);
    return b;
}
DI void xcd_barrier_complete(unsigned* bar, unsigned x, unsigned& nloc, unsigned& nx) {
    const unsigned G = gridDim.x * gridDim.y * gridDim.z;
    unsigned sum, cnt, mine, sp = 0u;
    for (;;) {
        sum = 0u; cnt = 0u; mine = 0u;
#pragma unroll
        for (unsigned j = 0; j < 16; ++j) { const unsigned c = xb_ld(&bar[XB_XCNT(j)]); sum += c; cnt += (c > 0u) ? 1u : 0u; mine = (j == x) ? c : mine; }
        if (sum == G) break;
        __builtin_amdgcn_s_sleep(1);
        if ((++sp & 255u) == 0u) { if (xb_ld(&bar[XB_TMO])) break; if (sp > XB_SPIN_CAP) { atomicAdd(&bar[XB_TMO], 1u); break; } }
    }
    nloc = mine > 0u ? mine : 1u; nx = cnt > 0u ? cnt : 1u;
}
DI void xcd_barrier(const XcdBarrier& b) {
    asm volatile("s_waitcnt vmcnt(0)" ::: "memory");
    __syncthreads();
    if (threadIdx.x == 0) {
        unsigned* bar = b.bar;
        __builtin_amdgcn_s_waitcnt(0);
        unsigned nloc = b.st[0], nx = b.st[1];
        if (nloc == 0u) { xcd_barrier_complete(bar, b.x, nloc, nx); b.st[0] = nloc; b.st[1] = nx; }
        const unsigned old = xb_add(&bar[XB_XSUB(b.x)], 1u);
        const unsigned gen = old / nloc;
        if (old + 1u == (gen + 1u) * nloc) {
            __builtin_amdgcn_fence(__ATOMIC_RELEASE, "agent");
            asm volatile("s_waitcnt vmcnt(0)" ::: "memory");
            const unsigned og = xb_add(&bar[XB_TOP], 1u);
            const unsigned tg = og / nx;
            if (og + 1u == (tg + 1u) * nx) xb_add(&bar[XB_TOPGEN], 1u);
            else XB_SPIN(xb_ld(&bar[XB_TOPGEN]) == tg, bar);
            __builtin_amdgcn_fence(__ATOMIC_ACQUIRE, "agent");
            xb_add(&bar[XB_XGEN(b.x)], 1u);
            asm volatile("s_waitcnt vmcnt(0)" ::: "memory");
        } else {
            XB_SPIN(xb_ld(&bar[XB_XGEN(b.x)]) == gen, bar);
            __builtin_amdgcn_fence(__ATOMIC_ACQUIRE, "agent");
            asm volatile("s_waitcnt vmcnt(0)" ::: "memory");
        }
    }
    __syncthreads();
}

constexpr int NPHASES = 20;
__global__ void __launch_bounds__(NTHREADS, 2) hybrid_fwd(KP P) {
    extern __shared__ __attribute__((aligned(16))) unsigned char lds[];
    const int bid = blockIdx.x, G = gridDim.x;
    const int NGW = G * NWAVES, NGT = G * NTHREADS;
#define gw (bid * NWAVES + (tid_l() >> 6))
#define gtid (bid * NTHREADS + tid_l())
    unsigned char* ws = P.ws;
    const int lo = P.ph_lo, hi = P.ph_hi;
#ifndef REPEAT_MASK
#define REPEAT_MASK 0
#endif
#define REP(k) for (int rep_ = 0; rep_ <= ((REPEAT_MASK >> (k)) & 1); ++rep_)
#ifdef ONLY_PHASES
#define IN(k) (((ONLY_PHASES >> (k)) & 1) && lo <= (k) && (k) < hi)
#else
#define IN(k) (lo <= (k) && (k) < hi)
#endif
    volatile LAS unsigned* bst = (volatile LAS unsigned*)(LAS unsigned char*)(lds + LDS_BYTES - 16);
    if (threadIdx.x == 0) { bst[0] = 0u; bst[1] = 0u; }
    __syncthreads();
    XcdBarrier xbar; xbar.bar = (unsigned*)(P.ws + M_BAR); xbar.x = 0; xbar.st = bst;
    if (hi - lo > 1) xbar = xcd_barrier_post((unsigned*)(P.ws + M_BAR), bst);
    if (lo == 0x7fffffff) cg::this_grid().sync();
#define SYNC_AFTER(k) do { if (IN(k) && IN((k) + 1)) { xcd_barrier(xbar); } } while (0)
    const bf16_t* Hb = (const bf16_t*)(ws + R_A);
    const bf16_t* CATb = (const bf16_t*)(ws + R_H);
    const bf16_t* HFFb = (const bf16_t*)(ws + R_HFF);

    if (IN(0)) REP(0) {
        for (int it = bid; it < 256; it += G) { if (it < 192) p0_ada_item(P, it, lds); else p0_s5_tables(P, it - 192, lds); }
        if (bid == 0) p0_consts(P);
        p0_weights(P, lds, gw, NGW, 0);
        __syncthreads();
    }
    SYNC_AFTER(0);
    if (IN(1)) REP(1) {
        modulate_rows(P, P.in[0], P.in[2], 0, 0, T, gw, NGW);
        for (int i = gtid; i < NC * 1024 / 4; i += NGT) ((f32x4*)(ws + M_XC))[i] = ((const f32x4*)P.in[2])[i];
        s5_expand(P, gtid, NGT);
    }
    SYNC_AFTER(1);
    if (IN(2)) REP(2) {
        { pg8::Gemm g{Hb, (const bf16_t*)(ws + W_IN0), T, 1280, 1024}; pg8::StaticOrder S; S.init(T, 1280, G, bid);
          pg8::EpiT<EPI_G1> E{P}; pg8::gemm_phase<pg8::EpiT<EPI_G1>, pg8::StaticOrder, true, true>((PG8_LAS unsigned char*)lds, g, S, E); }
    }
    SYNC_AFTER(2);
    if (IN(3)) REP(3) {
        { pg8::Gemm g{(const bf16_t*)(ws + R_C), (const bf16_t*)(ws + R_D2), 32 * S5MP, 256, 512, 3, 1}; pg8::StaticOrder S; S.init(32 * S5MP, 256, G, bid);
          pg8::EpiT<EPI_S5S> E{P}; pg8::gemm_phase<pg8::EpiT<EPI_S5S>, pg8::StaticOrder, true, true, S5K>((PG8_LAS unsigned char*)lds, g, S, E); }
        if (rep_ == 0) p3_norm_rows(P, gw, NGW);
    }
    SYNC_AFTER(3);
    if (IN(4)) REP(4) {
        if (bid < 32) s5_chain(P, bid);
        __syncthreads();
        const GP g1{(const bf16_t*)(ws + R_B), (const bf16_t*)(ws + W_QB), 0, 0, 672, 384, 384, T, 65, 3, 1, EPI_QRAW};
        const int vbid = (bid + 455 % G) % G;
        gemm_phase<EPI_QRAW>(P, g1, lds, vbid, G, 0);
        const GP g2{(const bf16_t*)(ws + R_B) + 384, (const bf16_t*)(ws + W_KVB), 0, 0, 672, 256, 256, T, 65, 4, 1, EPI_KV};
        gemm_phase<EPI_KV>(P, g2, lds, vbid, G, 195);
    }
    SYNC_AFTER(4);
    if (IN(5)) REP(5) {
        { pg8::Gemm g{(const bf16_t*)(ws + R_C), (const bf16_t*)(ws + R_D), 32 * S5MP, 512, 768, 3, 2}; pg8::StaticOrder S; S.init(32 * S5MP, 512, G, bid);
          pg8::EpiT<EPI_S5Y> E{P}; pg8::gemm_phase<pg8::EpiT<EPI_S5Y>, pg8::StaticOrder, true, true>((PG8_LAS unsigned char*)lds, g, S, E); }
        if (rep_ == 0) p5_finalize_rows(P, gw, NGW);
    }
    SYNC_AFTER(5);
    if (IN(6)) REP(6) {
        for (int u = bid; u < 520; u += G) { if (u < 512) mla_attn_unit(P, u >> 3, u & 7, lds); else mla_attn_unit(P, 64, u - 512, lds); }
        { pg8::Gemm g{(const bf16_t*)((const unsigned char*)P.out + O_GG), (const bf16_t*)(ws + W_GLU), T, 512, 512}; pg8::StaticOrder S; S.init(T, 512, G, (bid + G - 8) % G);
          pg8::EpiT<EPI_GLU> E{P}; pg8::gemm_phase<pg8::EpiT<EPI_GLU>, pg8::StaticOrder, true, true>((PG8_LAS unsigned char*)lds, g, S, E); }
    }
    SYNC_AFTER(6);
    if (IN(7)) REP(7) {
        { pg8::Gemm g{CATb, (const bf16_t*)(ws + W_OUT0), L, 1024, 1024}; pg8::StaticOrder S; S.init(L, 1024, G, bid);
          pg8::EpiT<EPI_RES_A0> E{P}; pg8::gemm_phase<pg8::EpiT<EPI_RES_A0>, pg8::StaticOrder, true, true>((PG8_LAS unsigned char*)lds, g, S, E); }
        if (rep_ == 0) {
            const GP gc{CATb + (size_t)L * 1024, (const bf16_t*)(ws + W_OUT0), 128, 128, 1024, 1024, 128, NC, 1, 4, 8, EPI_CTX_A0};
            gemm_phase<EPI_CTX_A0>(P, gc, lds, bid, G, 64); }
    }
    SYNC_AFTER(7);
    if (IN(8)) REP(8) modulate_rows(P, P.out, (const float*)(ws + M_XC), 0, 3, T, gw, NGW);
    SYNC_AFTER(8);
    if (IN(9)) REP(9) {
        { pg8::Gemm g{Hb, (const bf16_t*)(ws + W_13_0), T, 5632, 1024}; pg8::StaticOrder S; S.init(T, 5632, G, bid);
          pg8::EpiT<EPI_SWIGLU> E{P}; pg8::gemm_phase<pg8::EpiT<EPI_SWIGLU>, pg8::StaticOrder, true, true>((PG8_LAS unsigned char*)lds, g, S, E); }
    }
    SYNC_AFTER(9);
    if (IN(10)) REP(10) {
        { pg8::Gemm g{HFFb, (const bf16_t*)(ws + W_2_0), L, 1024, 2816}; pg8::StaticOrder S; S.init(L, 1024, G, bid);
          pg8::EpiT<EPI_RES_F0> E{P}; pg8::gemm_phase<pg8::EpiT<EPI_RES_F0>, pg8::StaticOrder, true, true>((PG8_LAS unsigned char*)lds, g, S, E); }
        {
            const GP gc{HFFb + (size_t)L * 2816, (const bf16_t*)(ws + W_2_0), 256, 256, 2816, 2816, 256, NC, 1, 4, 11, EPI_CTX_F0};
            gemm_phase<EPI_CTX_F0>(P, gc, lds, bid, G, 64); }
    }
    SYNC_AFTER(10);
    if (IN(11)) REP(11) modulate_rows(P, P.out, (const float*)(ws + M_XC), 1, 0, T, gw, NGW);
    SYNC_AFTER(11);
    if (IN(12)) REP(12) {
        { pg8::Gemm g{Hb, (const bf16_t*)(ws + W_IN1), T, 3328, 1024}; pg8::StaticOrder S; S.init(T, 3328, G, bid);
          pg8::EpiT<EPI_G8> E{P}; pg8::gemm_phase<pg8::EpiT<EPI_G8>, pg8::StaticOrder, true, true>((PG8_LAS unsigned char*)lds, g, S, E); }
        if (rep_ == 0) { const int nu = 65 * 13, rem = nu % G;
            if (rem != 0 && G - rem >= 64) { if (bid >= rem) p0_weights(P, lds, (bid - rem) * NWAVES + (tid_l() >> 6), (G - rem) * NWAVES, 1); }
            else p0_weights(P, lds, gw, NGW, 1);
            __syncthreads(); }
    }
    SYNC_AFTER(12);
    if (IN(13)) REP(13) {
        if (rep_ == 0) { if (G > 64) { if (bid >= 16) p13_finalize_rows(P, gw - 16 * NWAVES, NGW - 16 * NWAVES); } else p13_finalize_rows(P, gw, NGW); }
        for (int u = bid; u < 256 + 16; u += G) {
            if (u < 256) ssd_a_unit(P, u >> 1, u & 1, 0, 4, lds);
            else { const int v = u - 256, c = 128 + (v >> 3), h = v & 7; ssd_a_unit(P, c, h >> 2, h & 3, (h & 3) + 1, lds); }
        }
    }
    SYNC_AFTER(13);
    if (IN(14)) REP(14) {
        if (rep_ == 0) for (int q = bid; q < 256; q += G) ssd_chain(P, q, lds);
        for (int u = bid; u < 256; u += G) diff_attn_unit(P, u >> 2, u & 3, lds);
    }
    SYNC_AFTER(14);
    if (IN(15)) REP(15) { for (int u = bid; u < 256; u += G) ssd_c_unit(P, u >> 1, u & 1, lds); }
    SYNC_AFTER(15);
    if (IN(16)) REP(16) {
        { pg8::Gemm g{CATb, (const bf16_t*)(ws + W_OUT1), L, 1024, 1024}; pg8::StaticOrder S; S.init(L, 1024, G, bid);
          pg8::EpiT<EPI_RES_A1> E{P}; pg8::gemm_phase<pg8::EpiT<EPI_RES_A1>, pg8::StaticOrder, true, true>((PG8_LAS unsigned char*)lds, g, S, E); }
    }
    SYNC_AFTER(16);
    if (IN(17)) REP(17) modulate_rows(P, P.out, (const float*)(ws + M_XC), 1, 3, L, gw, NGW);
    SYNC_AFTER(17);
    if (IN(18)) REP(18) {
        { pg8::Gemm g{Hb, (const bf16_t*)(ws + W_13_1), L, 5632, 1024}; pg8::StaticOrder S; S.init(L, 5632, G, bid);
          pg8::EpiT<EPI_SWIGLU> E{P}; pg8::gemm_phase<pg8::EpiT<EPI_SWIGLU>, pg8::StaticOrder, true, true>((PG8_LAS unsigned char*)lds, g, S, E); }
    }
    SYNC_AFTER(18);
    if (IN(19)) REP(19) {
        { pg8::Gemm g{HFFb, (const bf16_t*)(ws + W_2_1), L, 1024, 2816}; pg8::StaticOrder S; S.init(L, 1024, G, bid);
          pg8::EpiT<EPI_RES_F1> E{P}; pg8::gemm_phase<pg8::EpiT<EPI_RES_F1>, pg8::StaticOrder, true, true>((PG8_LAS unsigned char*)lds, g, S, E); }
    }
#undef IN
#undef SYNC_AFTER
#undef gw
#undef gtid
}

extern "C" void kernel_launch(void* const* d_in, const int* in_sizes, int n_in, void* d_out, int out_size, void* d_ws, size_t ws_size, hipStream_t stream) {
    static int grid = 0;
    if (grid == 0) {
        if (n_in != 42 || out_size != L * DM || ws_size < WS_NEED) { fprintf(stderr, "kernel_launch: unexpected shapes n_in %d out %d ws %zu (need %zu)\n", n_in, out_size, ws_size, (size_t)WS_NEED); grid = -1; return; }
        int dev = 0, cus = 0, per_cu = 0;
        (void)hipGetDevice(&dev); (void)hipDeviceGetAttribute(&cus, hipDeviceAttributeMultiprocessorCount, dev);
        if (hipFuncSetAttribute((const void*)hybrid_fwd, hipFuncAttributeMaxDynamicSharedMemorySize, LDS_BYTES) != hipSuccess) { fprintf(stderr, "kernel_launch: hipFuncSetAttribute failed\n"); grid = -1; return; }
        if (hipOccupancyMaxActiveBlocksPerMultiprocessor(&per_cu, (const void*)hybrid_fwd, NTHREADS, LDS_BYTES) != hipSuccess || per_cu < 1) { fprintf(stderr, "kernel_launch: occupancy query failed (%d)\n", per_cu); per_cu = 1; }
        (void)hipGetLastError();
        grid = cus;
        fprintf(stderr, "kernel_launch: cus %d per_cu %d grid %d ws %zu need %zu\n", cus, per_cu, grid, ws_size, (size_t)WS_NEED);
    }
    if (grid < 0) return;
    KP p{};
    for (int i = 0; i < 42; ++i) p.in[i] = (const float*)d_in[i];
    p.out = (float*)d_out; p.ws = (unsigned char*)d_ws;
#if N_LAUNCH_MODE == 1
    for (int ph = 0; ph < NPHASES; ++ph) { p.ph_lo = ph; p.ph_hi = ph + 1; hipLaunchKernelGGL(hybrid_fwd, dim3(grid), dim3(NTHREADS), LDS_BYTES, stream, p); }
#else
    p.ph_lo = 0; p.ph_hi = NPHASES;
    if (hipMemsetAsync((unsigned char*)d_ws + M_BAR, 0, XCD_BAR_WORDS * 4, stream) != hipSuccess) { fprintf(stderr, "kernel_launch: memset failed\n"); return; }
    void* args[] = {&p};
    hipError_t e = hipLaunchCooperativeKernel((const void*)hybrid_fwd, dim3(grid), dim3(NTHREADS), args, LDS_BYTES, stream);
    if (e != hipSuccess) fprintf(stderr, "kernel_launch: cooperative launch failed: %s (grid %d)\n", hipGetErrorString(e), grid);
#endif
}
```

```cpp
#include <hip/hip_runtime.h>
#include <hip/hip_cooperative_groups.h>
#include <cstdio>
#include <cstdint>
namespace cg = cooperative_groups;

#ifndef N_LAUNCH_MODE
#define N_LAUNCH_MODE 0
#endif

typedef unsigned short bf16_t;
typedef short bf16x8 __attribute__((ext_vector_type(8)));
typedef short s16x4 __attribute__((ext_vector_type(4)));
typedef float f32x16 __attribute__((ext_vector_type(16)));
typedef float f32x4 __attribute__((ext_vector_type(4)));
typedef unsigned u32x4 __attribute__((ext_vector_type(4)));
typedef unsigned u32x2 __attribute__((ext_vector_type(2)));
#define DI __device__ __forceinline__
#define MFMA32(a, b, c) __builtin_amdgcn_mfma_f32_32x32x16_bf16((a), (b), (c), 0, 0, 0)

constexpr int L = 16384, NC = 256, T = L + NC, DM = 1024, DFF = 2816;
constexpr int NTHREADS = 512, NWAVES = 8;
constexpr float EPS = 1e-6f;
constexpr float LOG2E = 1.4426950408889634f;
constexpr float LAM_INIT = 0.35550906759f;
constexpr int S5T = 32, S5M = T / S5T  , S5K = 16 * S5T + 256  , S5N = 16 * S5T  , S5MP = 768  ;
constexpr int SQ = 128, SNC = T / SQ  ;

constexpr size_t al256(size_t x) { return (x + 255) / 256 * 256; }
constexpr size_t UB = (size_t)T * 1024;
constexpr size_t W_IN0 = 0;
constexpr size_t W_QB = W_IN0 + (size_t)1280 * 1024 * 2;
constexpr size_t W_KVB = W_QB + (size_t)768 * 384 * 2;
constexpr size_t W_GLU = W_KVB + (size_t)1024 * 256 * 2;
constexpr size_t W_OUT0 = W_GLU + (size_t)512 * 512 * 2;
constexpr size_t W_13_0 = W_OUT0 + (size_t)1024 * 1024 * 2;
constexpr size_t W_2_0 = W_13_0 + (size_t)5632 * 1024 * 2;
constexpr size_t W_IN1 = W_2_0 + (size_t)1024 * 2816 * 2;
constexpr size_t W_OUT1 = W_IN1 + (size_t)3328 * 1024 * 2;
constexpr size_t W_13_1 = W_OUT1 + (size_t)1024 * 1024 * 2;
constexpr size_t W_2_1 = W_13_1 + (size_t)5632 * 1024 * 2;
constexpr size_t W_END = W_2_1 + (size_t)1024 * 2816 * 2;
constexpr size_t M_MODS = al256(W_END);
constexpr size_t M_APOW = M_MODS + 4 * 6144 * 4;
constexpr size_t M_BB = M_APOW + (size_t)2 * 32 * 33 * 64 * 2 * 4;
constexpr size_t M_KT = M_BB + (size_t)2 * 32 * 64 * 16 * 2 * 4;
constexpr size_t M_ROPE16 = M_KT + (size_t)2 * 32 * 32 * 256 * 4;
constexpr size_t M_ROPE8 = M_ROPE16 + 256 * 16 * 2 * 4;
constexpr size_t M_CONST = M_ROPE8 + 256 * 8 * 2 * 4;
constexpr size_t M_XC = M_CONST + 256;
constexpr size_t M_DTR = M_XC + (size_t)NC * 1024 * 4;
constexpr size_t M_CS = M_DTR + (size_t)T * 16 * 4;
constexpr size_t M_DEC = M_CS + (size_t)T * 16 * 4;
constexpr size_t M_BAR = al256(M_DEC + 2 * SNC * 8 * 4);
constexpr size_t M_END = M_BAR + 3456 * 4;
constexpr size_t DYN0 = al256(M_END);
constexpr size_t R_A = DYN0;
constexpr size_t R_B = R_A + 2 * UB;
constexpr size_t R_C = R_B + (size_t)T * 672 * 2;
constexpr size_t R_D = R_C + (size_t)32 * S5MP * S5K * 2;
constexpr size_t R_D2 = R_D + (size_t)32 * S5N * S5K * 2;
constexpr size_t R_E = R_D2 + (size_t)32 * 256 * 512 * 2;
constexpr size_t R_F = R_E + (size_t)32 * S5M * 256 * 4;
constexpr size_t R_G = R_F + UB;
constexpr size_t R_END0 = R_G + (size_t)T * 768 * 2;
constexpr size_t R_H = R_A;
constexpr size_t R_HFF = R_B;
constexpr size_t R1_QK = R_B;
constexpr size_t R1_V = R1_QK + 2 * UB;
constexpr size_t R1_Z = R1_V + UB;
constexpr size_t R1_XBC = R1_Z + UB;
constexpr size_t R1_SS = R1_XBC + 2 * UB;
constexpr size_t R1_YP = R1_SS + (size_t)2 * SNC * 8 * 64 * 128 * 2;
constexpr size_t R1_CC = R1_YP + UB;
constexpr size_t R1_END = R1_CC + (size_t)T * 256 * 2;
constexpr size_t WS_NEED = (R_END0 > R1_END ? R_END0 : R1_END);
static_assert(R_HFF + (size_t)T * 2816 * 2 <= (size_t)256 * 1024 * 1024, "HFF fits");
static_assert(WS_NEED <= (size_t)256 * 1024 * 1024, "workspace fits in 256 MiB");
constexpr size_t O_Q0 = 0;
constexpr size_t O_KN = O_Q0 + (size_t)T * 768 * 2;
constexpr size_t O_GG = O_KN + UB;
static_assert(O_GG + UB <= (size_t)L * 1024 * 4, "d_out scratch fits");

constexpr int LDS_BYTES = 144 * 1024;

struct KP {
    const float* in[42];
    float* out;
    unsigned char* ws;
    int ph_lo, ph_hi;
};

typedef float f32x2_t __attribute__((ext_vector_type(2)));
typedef __bf16 bf16x2_t __attribute__((ext_vector_type(2)));
DI unsigned cvtpk(float lo, float hi) { const f32x2_t v = {lo, hi}; const bf16x2_t r = __builtin_convertvector(v, bf16x2_t); return __builtin_bit_cast(unsigned, r); }
DI bf16_t f2bf(float x) { const __bf16 b = (__bf16)x; return __builtin_bit_cast(unsigned short, b); }
DI float bf2f(bf16_t b) { return __uint_as_float((unsigned)b << 16); }
DI float bflo(unsigned w) { return __uint_as_float(w << 16); }
DI float bfhi(unsigned w) { return __uint_as_float(w & 0xffff0000u); }
DI int crow(int r, int hi) { return (r & 3) + 8 * (r >> 2) + 4 * hi; }
DI int tid_l() { int t = threadIdx.x; asm volatile("" : "+v"(t)); return t; }
DI float wave_sum(float v) {
#pragma unroll
    for (int o = 1; o < 64; o <<= 1) v += __shfl_xor(v, o);
    return v;
}
DI float silu_f(float x) { return x / (1.f + __expf(-x)); }
DI float sigmoid_f(float x) { return 1.f / (1.f + __expf(-x)); }
DI float gelu_tanh(float x) { const float u = 0.7978845608028654f * (x + 0.044715f * x * x * x); const float t = 1.f - 2.f / (1.f + __expf(2.f * u)); return 0.5f * x * (1.f + t); }
DI float softplus_f(float x) { return fmaxf(x, 0.f) + log1pf(__expf(-fabsf(x))); }

struct GP { const bf16_t* A; const bf16_t* Bt; long aBatch, bBatch; int lda, ldb, K, Mtot, mt, nt, nb, epi; };
enum { EPI_G1 = 0, EPI_QRAW, EPI_KV, EPI_S5S, EPI_S5Y, EPI_GLU, EPI_RES_A0, EPI_SWIGLU, EPI_RES_F0, EPI_G8, EPI_RES_A1, EPI_RES_F1, EPI_CTX_A0, EPI_CTX_F0 };

template <int EPI> DI void epi_put(const KP& P, int b, int row, int col, float v) {
    unsigned char* ws = P.ws;
    if constexpr (EPI == EPI_G1) {
        if (col < 672) ((bf16_t*)(ws + R_B))[(size_t)row * 672 + col] = f2bf(v);
        else if (col < 1184) { const int cc = col - 672, g = cc >> 4, c = cc & 15, m = row >> 5, s = row & 31;
            ((bf16_t*)(ws + R_C))[((size_t)g * S5MP + m) * S5K + s * 16 + c] = f2bf(v); }
    } else if constexpr (EPI == EPI_QRAW) { ((bf16_t*)((unsigned char*)P.out + O_Q0))[(size_t)row * 768 + col] = f2bf(v);
    } else if constexpr (EPI == EPI_KV) { const int h = col >> 7, w = col & 127;
        if (w < 64) ((bf16_t*)((unsigned char*)P.out + O_KN))[(size_t)row * 512 + h * 64 + w] = f2bf(v);
        else ((bf16_t*)(ws + R_F))[(size_t)row * 512 + h * 64 + (w - 64)] = f2bf(v);
    } else if constexpr (EPI == EPI_S5S) { ((float*)(ws + R_E))[((size_t)b * S5M + row) * 256 + col] = v;
    } else if constexpr (EPI == EPI_S5Y) { const int t = col >> 4, ch = col & 15; const size_t trow = (size_t)row * 32 + t;
        ((bf16_t*)((unsigned char*)P.out + O_GG))[trow * 512 + b * 16 + ch] = f2bf(gelu_tanh(v));
    } else if constexpr (EPI == EPI_GLU) { const float g = bf2f(((const bf16_t*)((unsigned char*)P.out + O_GG))[(size_t)row * 512 + col]);
        ((bf16_t*)(ws + R_H))[(size_t)row * 1024 + 512 + col] = f2bf(g * sigmoid_f(v + P.in[26][col]));
    } else if constexpr (EPI == EPI_RES_A0) { const float* mods = (const float*)(ws + M_MODS);
        if (row < L) P.out[(size_t)row * 1024 + col] = P.in[0][(size_t)row * 1024 + col] + mods[0 * 6144 + 2048 + col] * v;
        else ((float*)(ws + M_XC))[(size_t)(row - L) * 1024 + col] = P.in[2][(size_t)(row - L) * 1024 + col] + mods[1 * 6144 + 2048 + col] * v;
    } else if constexpr (EPI == EPI_RES_F0) { const float* mods = (const float*)(ws + M_MODS);
        if (row < L) P.out[(size_t)row * 1024 + col] += mods[0 * 6144 + 5120 + col] * v;
        else ((float*)(ws + M_XC))[(size_t)(row - L) * 1024 + col] += mods[1 * 6144 + 5120 + col] * v;
    } else if constexpr (EPI == EPI_G8) {
        if (col < 1024) ((bf16_t*)(ws + R1_QK))[(size_t)row * 1024 + col] = f2bf(v);
        else if (col < 1536) ((bf16_t*)(ws + R1_V))[(size_t)row * 512 + col - 1024] = f2bf(v);
        else if (col < 2048) ((bf16_t*)(ws + R1_Z))[(size_t)row * 512 + col - 1536] = f2bf(v);
        else if (col < 3072) ((bf16_t*)(ws + R1_XBC))[(size_t)row * 1024 + col - 2048] = f2bf(v);
        else if (col < 3088) ((float*)(ws + M_DTR))[(size_t)row * 16 + col - 3072] = v;
    } else if constexpr (EPI == EPI_RES_A1) { const float* mods = (const float*)(ws + M_MODS);
        P.out[(size_t)row * 1024 + col] += mods[2 * 6144 + 2048 + col] * v;
    } else if constexpr (EPI == EPI_RES_F1) { const float* mods = (const float*)(ws + M_MODS);
        P.out[(size_t)row * 1024 + col] += mods[2 * 6144 + 5120 + col] * v;
    } else if constexpr (EPI == EPI_CTX_A0) { const float* mods = (const float*)(ws + M_MODS);
        atomicAdd((float*)(ws + M_XC) + (size_t)row * 1024 + col, mods[1 * 6144 + 2048 + col] * v);
    } else if constexpr (EPI == EPI_CTX_F0) { const float* mods = (const float*)(ws + M_MODS);
        atomicAdd((float*)(ws + M_XC) + (size_t)row * 1024 + col, mods[1 * 6144 + 5120 + col] * v);
    }
}
template <int EPI> DI void epi_all(const KP& P, const f32x16 (&acc)[4][2], int b, int m0, int n0, int Mtot, int wr, int wc, int r32, int hi) {
    const int col = n0 + wc * 32 + r32;
#pragma unroll
    for (int i = 0; i < 4; ++i)
#pragma unroll
        for (int r = 0; r < 16; ++r) {
            const int row = m0 + wr * 128 + i * 32 + crow(r, hi);
            bool ok = true;
            if constexpr (EPI == EPI_S5S || EPI == EPI_S5Y) ok = row < Mtot;
            if (ok) {
                if constexpr (EPI == EPI_SWIGLU) ((bf16_t*)(P.ws + R_HFF))[(size_t)row * DFF + (n0 >> 1) + (col - n0)] = f2bf(silu_f(acc[i][0][r]) * acc[i][1][r]);
                else { epi_put<EPI>(P, b, row, col, acc[i][0][r]); epi_put<EPI>(P, b, row, col + 128, acc[i][1][r]); }
            }
            if ((r & 3) == 3) __builtin_amdgcn_sched_barrier(0);
        }
}

template <int EPI> DI void gemm_unit(const KP& P, const GP& g, int b, int pm, int pn, unsigned char* lds) {
    const int tid = tid_l(), lane = tid & 63, wid = tid >> 6, wr = wid >> 2, wc = wid & 3, r32 = lane & 31, hi = lane >> 5;
    const int m0 = pm * 256, n0 = pn * 256, K = g.K, nk = K / 64;
    const bf16_t* A = g.A + (size_t)b * g.aBatch; const bf16_t* Bt = g.Bt + (size_t)b * g.bBatch;
    const int sc = tid & 7, sr = tid >> 3;
    int aoff[4], boff[4];
#pragma unroll
    for (int i = 0; i < 4; ++i) { int ar = m0 + sr + 64 * i; ar = ar < g.Mtot ? ar : g.Mtot - 1; aoff[i] = ar * g.lda + sc * 8; boff[i] = (n0 + sr + 64 * i) * g.ldb + sc * 8; }
    const int woff = sr * 128 + ((sc ^ ((sr >> 1) & 7)) << 4);
    const int xs = (r32 >> 1) & 7;
    int rdo[4];
#pragma unroll
    for (int kk = 0; kk < 4; ++kk) rdo[kk] = (((kk * 2 + hi) ^ xs) << 4);
    const int arow = (wr * 128 + r32) * 128, brow = (wc * 32 + r32) * 128;
    f32x16 acc[4][2];
#pragma unroll
    for (int i = 0; i < 4; ++i)
#pragma unroll
        for (int j = 0; j < 2; ++j)
#pragma unroll
            for (int r = 0; r < 16; ++r) acc[i][j][r] = 0.f;
    u32x4 ra[4], rb[4];
#pragma unroll
    for (int i = 0; i < 4; ++i) { ra[i] = *(const u32x4*)(A + aoff[i]); rb[i] = *(const u32x4*)(Bt + boff[i]); }
#pragma unroll
    for (int i = 0; i < 4; ++i) { *(u32x4*)(lds + woff + i * 8192) = ra[i]; *(u32x4*)(lds + 32768 + woff + i * 8192) = rb[i]; }
    __syncthreads();
    for (int kt = 0; kt < nk; ++kt) {
        unsigned char* cur = lds + (kt & 1) * 65536; unsigned char* nxt = lds + ((kt + 1) & 1) * 65536;
        const bool more = kt + 1 < nk;
        if (more) {
            const int k0 = (kt + 1) * 64;
#pragma unroll
            for (int i = 0; i < 4; ++i) { ra[i] = *(const u32x4*)(A + aoff[i] + k0); rb[i] = *(const u32x4*)(Bt + boff[i] + k0); }
        }
#pragma unroll
        for (int kk = 0; kk < 4; ++kk) {
            bf16x8 af[4], bfr[2];
#pragma unroll
            for (int i = 0; i < 4; ++i) af[i] = *(const bf16x8*)(cur + arow + i * 4096 + rdo[kk]);
#pragma unroll
            for (int j = 0; j < 2; ++j) bfr[j] = *(const bf16x8*)(cur + 32768 + brow + j * 16384 + rdo[kk]);
#pragma unroll
            for (int i = 0; i < 4; ++i)
#pragma unroll
                for (int j = 0; j < 2; ++j) acc[i][j] = MFMA32(af[i], bfr[j], acc[i][j]);
        }
        if (more) {
#pragma unroll
            for (int i = 0; i < 4; ++i) { *(u32x4*)(nxt + woff + i * 8192) = ra[i]; *(u32x4*)(nxt + 32768 + woff + i * 8192) = rb[i]; }
        }
        __syncthreads();
    }
    int hiv = hi; asm volatile("" : "+v"(hiv));
    epi_all<EPI>(P, acc, b, m0, n0, g.Mtot, wr, wc, r32, hiv);
}

template <int EPI> DI void gemm_phase(const KP& P, const GP& g, unsigned char* lds, int bid, int G, int ubase = 0) {
    const int nu = g.nb * g.mt * g.nt, per = g.mt * g.nt;
    int u = bid; if (u < ubase) u += ((ubase - u + G - 1) / G) * G;
    for (; u < ubase + nu; u += G) {
        const int v = u - ubase, b = v / per, rem = v % per, pm = rem / g.nt, pn = rem % g.nt;
        gemm_unit<EPI>(P, g, b, pm, pn, lds);
    }
}

template <int OFF> DI s16x4 tr_read(int vb) { s16x4 r; asm volatile("ds_read_b64_tr_b16 %0, %1 offset:%2" : "=&v"(r) : "v"(vb), "i"(OFF) : "memory"); return r; }
DI int v_rd_base(int lane) { return ((lane & 3) << 3) | (((lane >> 2) & 3) << 6) | (((lane >> 4) & 1) << 5) | (((lane >> 5) & 1) << 8); }

template <int DVB, int D0> struct PVOne {
    static DI void run(f32x16& od, int vb, bf16x8 pa0, bf16x8 pa1, bf16x8 pa2, bf16x8 pa3) {
        constexpr int KSB = 2 * DVB * 512, HB = DVB * 512;
#define PKV(Lq, Hq) (bf16x8){Lq[0], Lq[1], Lq[2], Lq[3], Hq[0], Hq[1], Hq[2], Hq[3]}
        if constexpr (DVB == 4) {
            { const s16x4 l0 = tr_read<D0 * 512 + 0 * KSB>(vb), h0 = tr_read<D0 * 512 + 0 * KSB + HB>(vb);
              const s16x4 l1 = tr_read<D0 * 512 + 1 * KSB>(vb), h1 = tr_read<D0 * 512 + 1 * KSB + HB>(vb);
              asm volatile("s_waitcnt lgkmcnt(0)" ::: "memory"); __builtin_amdgcn_sched_barrier(0);
              od = MFMA32(pa0, PKV(l0, h0), od); od = MFMA32(pa1, PKV(l1, h1), od); }
            { const s16x4 l2 = tr_read<D0 * 512 + 2 * KSB>(vb), h2 = tr_read<D0 * 512 + 2 * KSB + HB>(vb);
              const s16x4 l3 = tr_read<D0 * 512 + 3 * KSB>(vb), h3 = tr_read<D0 * 512 + 3 * KSB + HB>(vb);
              asm volatile("s_waitcnt lgkmcnt(0)" ::: "memory"); __builtin_amdgcn_sched_barrier(0);
              od = MFMA32(pa2, PKV(l2, h2), od); od = MFMA32(pa3, PKV(l3, h3), od); }
        } else {
        const s16x4 l0 = tr_read<D0 * 512 + 0 * KSB>(vb), h0 = tr_read<D0 * 512 + 0 * KSB + HB>(vb);
        const s16x4 l1 = tr_read<D0 * 512 + 1 * KSB>(vb), h1 = tr_read<D0 * 512 + 1 * KSB + HB>(vb);
        const s16x4 l2 = tr_read<D0 * 512 + 2 * KSB>(vb), h2 = tr_read<D0 * 512 + 2 * KSB + HB>(vb);
        const s16x4 l3 = tr_read<D0 * 512 + 3 * KSB>(vb), h3 = tr_read<D0 * 512 + 3 * KSB + HB>(vb);
        asm volatile("s_waitcnt lgkmcnt(0)" ::: "memory"); __builtin_amdgcn_sched_barrier(0);
        od = MFMA32(pa0, PKV(l0, h0), od); od = MFMA32(pa1, PKV(l1, h1), od); od = MFMA32(pa2, PKV(l2, h2), od); od = MFMA32(pa3, PKV(l3, h3), od);
        }
#undef PKV
    }
};

#define SBAR() __builtin_amdgcn_sched_barrier(0)
DI void sm_partial(f32x16& p0) {
#pragma unroll
    for (int r = 0; r < 16; ++r) p0[r] = __builtin_amdgcn_exp2f(p0[r]);
}
DI void sm_finish(f32x16& p0, f32x16& p1, float& l_reg, bf16x8& pa0, bf16x8& pa1, bf16x8& pa2, bf16x8& pa3) {
#pragma unroll
    for (int r = 0; r < 16; ++r) p1[r] = __builtin_amdgcn_exp2f(p1[r]);
    float ps = 0.f;
#pragma unroll
    for (int r = 0; r < 16; ++r) ps += p0[r] + p1[r];
    l_reg += ps;
#define PK4(Pv, BASE, OUT) do { unsigned a0 = cvtpk(Pv[BASE + 0], Pv[BASE + 1]), a1 = cvtpk(Pv[BASE + 2], Pv[BASE + 3]);   \
    unsigned b0_ = cvtpk(Pv[BASE + 4], Pv[BASE + 5]), b1_ = cvtpk(Pv[BASE + 6], Pv[BASE + 7]);                              \
    auto r0 = __builtin_amdgcn_permlane32_swap(a0, b0_, false, false); auto r1 = __builtin_amdgcn_permlane32_swap(a1, b1_, false, false); \
    u32x4 w = {r0[0], r1[0], r0[1], r1[1]}; OUT = *reinterpret_cast<bf16x8*>(&w); } while (0)
    PK4(p0, 0, pa0); PK4(p0, 8, pa1); PK4(p1, 0, pa2); PK4(p1, 8, pa3);
#undef PK4
}
template <int DVB, int B> struct PVB {
    static constexpr int D0 = B % DVB, KH = B / DVB, KSB = 2 * DVB * 512, HB = DVB * 512;
    static DI void issue(int vb, s16x4 (&t)[4]) {
        t[0] = tr_read<D0 * 512 + (2 * KH) * KSB>(vb); t[1] = tr_read<D0 * 512 + (2 * KH) * KSB + HB>(vb);
        t[2] = tr_read<D0 * 512 + (2 * KH + 1) * KSB>(vb); t[3] = tr_read<D0 * 512 + (2 * KH + 1) * KSB + HB>(vb);
    }
    static DI void run(f32x16 (&o)[DVB], int vb, const bf16x8 (&pa)[4], s16x4 (&cur)[4]) {
        constexpr int NB = 2 * DVB;
        s16x4 nxt[4];
        if constexpr (B + 1 < NB) { PVB<DVB, B + 1>::issue(vb, nxt); asm volatile("s_waitcnt lgkmcnt(4)" ::: "memory"); }
        else asm volatile("s_waitcnt lgkmcnt(0)" ::: "memory");
        __builtin_amdgcn_sched_barrier(0);
#define PKV(Lq, Hq) (bf16x8){Lq[0], Lq[1], Lq[2], Lq[3], Hq[0], Hq[1], Hq[2], Hq[3]}
        o[D0] = MFMA32(pa[2 * KH], PKV(cur[0], cur[1]), o[D0]);
        o[D0] = MFMA32(pa[2 * KH + 1], PKV(cur[2], cur[3]), o[D0]);
#undef PKV
        if constexpr (B + 1 < NB) PVB<DVB, B + 1>::run(o, vb, pa, nxt);
    }
};

#define LASP __attribute__((address_space(3)))
template <int KS, int DVB>
DI void attn_core(const bf16_t* __restrict__ Qb, int ldq, const bf16_t* __restrict__ Kb, int ldk, const bf16_t* __restrict__ Vb, int ldv, int nkeys, float negMc,
                  f32x16 (&o)[DVB], float& l_out, unsigned char* lds) {
    constexpr int KA = 8192, KBB = (KS == 6) ? 4096 : 0, KTILE = KA + KBB, VTILE = 64 * DVB * 64, SLOT = KTILE + VTILE;
    constexpr int NKI = KTILE / 1024, NVI = VTILE / 1024;
    const int tid = tid_l(), lane = tid & 63, wid = __builtin_amdgcn_readfirstlane(tid >> 6), r32 = lane & 31, hi = lane >> 5;
    (void)negMc;
    bf16x8 qr[KS];
    { const bf16_t* Qw = Qb + (size_t)(wid * 32 + r32) * ldq + hi * 8;
#pragma unroll
      for (int d0 = 0; d0 < KS; ++d0) qr[d0] = *(const bf16x8*)(Qw + d0 * 16); }
#pragma unroll
    for (int d = 0; d < DVB; ++d)
#pragma unroll
        for (int r = 0; r < 16; ++r) o[d][r] = 0.f;
    float l_reg = 0.f;
    const f32x16 czero = {0.f, 0.f, 0.f, 0.f, 0.f, 0.f, 0.f, 0.f, 0.f, 0.f, 0.f, 0.f, 0.f, 0.f, 0.f, 0.f};
    int ksrc0, ksrc1 = 0, vsrc0, vsrc1 = 0;
    { const int p = wid * 64 + lane, row = p >> 3, slot = p & 7, ch = slot ^ ((row >> 1) & 7); ksrc0 = row * ldk + ch * 8; }
    if constexpr (KS == 6) { const int p = (wid & 3) * 64 + lane, row = p >> 2, slot = p & 3, ch = slot ^ ((row >> 2) & 3); ksrc1 = row * ldk + 64 + ch * 8; }
    { const int p = wid * 64 + lane, st = p >> 5, row8 = (p & 31) >> 2, piece = p & 3, kg_ = st / DVB, cb = st % DVB, kk = kg_ * 8 + row8;
      const int k = (kk & ~0xC) | ((kk & 4) << 1) | ((kk & 8) >> 1); vsrc0 = k * ldv + cb * 32 + piece * 8; }
    if constexpr (DVB == 4) { const int p = (wid + 8) * 64 + lane, st = p >> 5, row8 = (p & 31) >> 2, piece = p & 3, kg_ = st / DVB, cb = st % DVB, kk = kg_ * 8 + row8;
      const int k = (kk & ~0xC) | ((kk & 4) << 1) | ((kk & 8) >> 1); vsrc1 = k * ldv + cb * 32 + piece * 8; }
    const bool kb_wave = (KS == 6) && (wid < 4);
    constexpr int NSLOT = (KS == 6) ? 6 : 5, PD = NSLOT - 1;
    const int NT = nkeys / 64;
    LASP unsigned char* L3 = (LASP unsigned char*)lds;
#define A_ISSUE(j) do { const int sl_ = ((j) % NSLOT) * SLOT; const bf16_t* kt_ = Kb + (size_t)(j) * 64 * ldk; const bf16_t* vt_ = Vb + (size_t)(j) * 64 * ldv; \
        __builtin_amdgcn_global_load_lds((const unsigned*)(kt_ + ksrc0), (LASP unsigned*)(L3 + sl_ + wid * 1024), 16, 0, 0); \
        if (kb_wave) __builtin_amdgcn_global_load_lds((const unsigned*)(kt_ + ksrc1), (LASP unsigned*)(L3 + sl_ + KA + (wid & 3) * 1024), 16, 0, 0); \
        __builtin_amdgcn_global_load_lds((const unsigned*)(vt_ + vsrc0), (LASP unsigned*)(L3 + sl_ + KTILE + wid * 1024), 16, 0, 0); \
        if constexpr (DVB == 4) __builtin_amdgcn_global_load_lds((const unsigned*)(vt_ + vsrc1), (LASP unsigned*)(L3 + sl_ + KTILE + (wid + 8) * 1024), 16, 0, 0); } while (0)
#define A_WAIT1() do { if constexpr (DVB == 4) asm volatile("s_waitcnt vmcnt(%0)" :: "n"((PD - 1) * 3) : "memory"); \
        else { if (kb_wave) asm volatile("s_waitcnt vmcnt(%0)" :: "n"((PD - 1) * 3) : "memory"); else asm volatile("s_waitcnt vmcnt(%0)" :: "n"((PD - 1) * 2) : "memory"); } } while (0)
    const int kax = (r32 >> 1) & 7, kbx = (r32 >> 2) & 3;
    const int vb0 = (int)(uintptr_t)(lds + KTILE) + v_rd_base(lane);
    A_ISSUE(0);
#pragma unroll
    for (int t = 1; t < PD; ++t) if (t < NT) A_ISSUE(t);
    if (NT >= PD) A_WAIT1(); else asm volatile("s_waitcnt vmcnt(0)" ::: "memory");
    __builtin_amdgcn_s_barrier();
    for (int j = 0; j < NT; ++j) {
        if (j + PD < NT) A_ISSUE(j + PD);
        const unsigned char* Kt = lds + (j % NSLOT) * SLOT;
        f32x16 p0, p1;
        { const int off = ((hi ^ kax) << 4);
          const bf16x8 b0 = *(const bf16x8*)(Kt + r32 * 128 + off), b1 = *(const bf16x8*)(Kt + (32 + r32) * 128 + off);
          p0 = MFMA32(b0, qr[0], czero); p1 = MFMA32(b1, qr[0], czero); }
#pragma unroll
        for (int d0 = 1; d0 < 4; ++d0) { const int off = (((d0 * 2 + hi) ^ kax) << 4);
            const bf16x8 b0 = *(const bf16x8*)(Kt + r32 * 128 + off), b1 = *(const bf16x8*)(Kt + (32 + r32) * 128 + off);
            p0 = MFMA32(b0, qr[d0], p0); p1 = MFMA32(b1, qr[d0], p1); }
        if constexpr (KS == 6) {
#pragma unroll
            for (int d0 = 4; d0 < 6; ++d0) { const int off = ((((d0 - 4) * 2 + hi) ^ kbx) << 4);
                const bf16x8 b0 = *(const bf16x8*)(Kt + KA + r32 * 64 + off), b1 = *(const bf16x8*)(Kt + KA + (32 + r32) * 64 + off);
                p0 = MFMA32(b0, qr[d0], p0); p1 = MFMA32(b1, qr[d0], p1); }
        }
        const int vb = vb0 + (j % NSLOT) * SLOT;
        s16x4 tv0[4];
        __builtin_amdgcn_sched_barrier(0);
        PVB<DVB, 0>::issue(vb, tv0);
        float ps = 0.f;
#pragma unroll
        for (int r = 0; r < 16; ++r) { p0[r] = __builtin_amdgcn_exp2f(p0[r]); p1[r] = __builtin_amdgcn_exp2f(p1[r]); ps += p0[r] + p1[r]; }
        l_reg += ps;
        bf16x8 pa[4];
#define PK4(Pv, BASE, OUT) do { unsigned a0 = cvtpk(Pv[BASE + 0], Pv[BASE + 1]), a1 = cvtpk(Pv[BASE + 2], Pv[BASE + 3]);   \
    unsigned b0_ = cvtpk(Pv[BASE + 4], Pv[BASE + 5]), b1_ = cvtpk(Pv[BASE + 6], Pv[BASE + 7]);                              \
    auto r0 = __builtin_amdgcn_permlane32_swap(a0, b0_, false, false); auto r1 = __builtin_amdgcn_permlane32_swap(a1, b1_, false, false); \
    u32x4 w = {r0[0], r1[0], r0[1], r1[1]}; OUT = *reinterpret_cast<bf16x8*>(&w); } while (0)
        PK4(p0, 0, pa[0]); PK4(p0, 8, pa[1]); PK4(p1, 0, pa[2]); PK4(p1, 8, pa[3]);
#undef PK4
        PVB<DVB, 0>::run(o, vb, pa, tv0);
        if (j + PD < NT) A_WAIT1(); else asm volatile("s_waitcnt vmcnt(0)" ::: "memory");
        __builtin_amdgcn_s_barrier();
    }
#undef A_ISSUE
#undef A_WAIT1
    { auto rr = __builtin_amdgcn_permlane32_swap(__float_as_uint(l_reg), __float_as_uint(l_reg), false, false);
      l_out = __uint_as_float(rr[0]) + __uint_as_float(rr[1]); }
}

#define PIN(x) asm volatile("" : "+v"(x))
typedef short v4i16_t __attribute__((ext_vector_type(4)));
DI s16x4 vtr_ld(const unsigned char* p) { return __builtin_bit_cast(s16x4, __builtin_amdgcn_ds_read_tr16_b64_v4i16((__attribute__((address_space(3))) v4i16_t*)(unsigned)(uintptr_t)p)); }
DI void mla_core_hi(const bf16_t* __restrict__ Qb, const bf16_t* __restrict__ Kb, const bf16_t* __restrict__ Vb, int nkeys, f32x16 (&o)[2], float& l_out, unsigned char* lds) {
    constexpr int ldq = 768, ldk = 768, ldv = 512, KSL = 12288, VSL = 8192, LDS_K = 0, LDS_V = 3 * KSL;
    const int tid = tid_l(), lane = tid & 63, r32 = lane & 31, hi = lane >> 5; const int wid = __builtin_amdgcn_readfirstlane(tid >> 6);
    const int NT = nkeys / 64;
    LASP unsigned char* L3 = (LASP unsigned char*)lds;
    const bf16_t* ksrc0 = Kb + (size_t)lane * ldk + wid * 8;
    const bf16_t* ksrc1 = Kb + (size_t)lane * ldk + (8 + (wid & 3)) * 8;
    const bf16_t* vsrc = Vb + (size_t)(16 * (wid & 3) + (lane >> 2)) * ldv + (wid >> 2) * 32 + (lane & 3) * 8;
#define DMA_K(t, slot) do { __builtin_amdgcn_global_load_lds((const unsigned*)(ksrc0 + (size_t)(t) * 64 * ldk), (LASP unsigned*)(L3 + LDS_K + (slot) * KSL + wid * 1024), 16, 0, 0); \
                            __builtin_amdgcn_global_load_lds((const unsigned*)(ksrc1 + (size_t)(t) * 64 * ldk), (LASP unsigned*)(L3 + LDS_K + (slot) * KSL + (8 + (wid & 3)) * 1024), 16, 0, 0); } while (0)
#define DMA_V(t, slot) __builtin_amdgcn_global_load_lds((const unsigned*)(vsrc + (size_t)(t) * 64 * ldv), (LASP unsigned*)(L3 + LDS_V + (slot) * VSL + wid * 1024), 16, 0, 0)
#define WAIT_BAR(N) asm volatile("s_waitcnt vmcnt(" #N ") lgkmcnt(0)\n\ts_barrier" ::: "memory")
    const unsigned char* vp0 = lds + LDS_V + ((lane >> 4) & 1) * 32 + (lane & 3) * 8 + (4 * hi + ((lane & 15) >> 2)) * 64;
    const unsigned char* kp0 = lds + LDS_K + hi * 1024 + r32 * 16;
    DMA_K(0, 0); DMA_V(0, 0); DMA_K(1, 1);
    bf16x8 qr[6];
#pragma unroll
    for (int d0 = 0; d0 < 6; ++d0) qr[d0] = *(const bf16x8*)(Qb + (size_t)(wid * 32 + r32) * ldq + d0 * 16 + hi * 8);
    float l_reg = 0.f;
#pragma unroll
    for (int d = 0; d < 2; ++d)
#pragma unroll
        for (int r = 0; r < 16; ++r) o[d][r] = 0.f;
    const f32x16 zero16 = {0.f, 0.f, 0.f, 0.f, 0.f, 0.f, 0.f, 0.f, 0.f, 0.f, 0.f, 0.f, 0.f, 0.f, 0.f, 0.f};
    f32x16 pA0, pA1, pB0, pB1; bf16x8 kf[12]; s16x4 vlo[8], vhi[8]; u32x4 pw0, pw1, pw2, pw3;
    int sl_prev = 0, sl_cur = 0, sl_next = 1;
#define ROT() do { sl_prev = sl_cur; sl_cur = sl_next; sl_next = (sl_next == 2) ? 0 : sl_next + 1; } while (0)
#define KLOAD2(base, d0) do { kf[2 * (d0)] = *(const bf16x8*)((base) + (d0) * 2048); kf[2 * (d0) + 1] = *(const bf16x8*)((base) + (d0) * 2048 + 512); } while (0)
#define QKT(C0, C1) do { C0 = MFMA32(kf[0], qr[0], zero16); C1 = MFMA32(kf[1], qr[0], zero16); \
        _Pragma("unroll") for (int d0 = 1; d0 < 6; ++d0) { C0 = MFMA32(kf[2 * d0], qr[d0], C0); C1 = MFMA32(kf[2 * d0 + 1], qr[d0], C1); } } while (0)
    DMA_K(2, 2);
    WAIT_BAR(5);
    _Pragma("unroll") for (int d0 = 0; d0 < 6; ++d0) KLOAD2(kp0, d0);
    QKT(pA0, pA1);
#pragma unroll
    for (int r = 0; r < 16; ++r) pA0[r] = __builtin_amdgcn_exp2f(pA0[r]);
    WAIT_BAR(0);
    DMA_K(3, 0); DMA_V(1, 1); ROT();
    _Pragma("unroll") for (int d0 = 0; d0 < 6; ++d0) KLOAD2(kp0 + sl_cur * KSL, d0);
    WAIT_BAR(3);
#define PKW(Pv, i) cvtpk(Pv[i], Pv[(i) + 1])
#define PAF(k) __builtin_bit_cast(bf16x8, pw##k)
#define VFR(i) (bf16x8){vlo[i][0], vlo[i][1], vlo[i][2], vlo[i][3], vhi[i][0], vhi[i][1], vhi[i][2], vhi[i][3]}
#define VRD(i) do { vlo[i] = vtr_ld(vp_ + (((i) >> 2) * 4096 + ((i) & 3) * 1024)); vhi[i] = vtr_ld(vp_ + (((i) >> 2) * 4096 + ((i) & 3) * 1024 + 512)); } while (0)
#define KRD(G, d0) do { if (G) { KLOAD2(kp0 + sl_next * KSL, d0); SBAR(); } } while (0)
#define GAPA(MF, a0, a1, a2, a3, W0, W1, PW) do { MF; sacc += a0; sacc += a1; sacc += a2; sacc += a3; W0; W1; PIN(PW); PIN(sacc); SBAR(); } while (0)
#define GAPX(MF, X, i, a0, a1, a2, W0, PW) do { MF; X[i] = __builtin_amdgcn_exp2f(X[i]); X[(i) + 1] = __builtin_amdgcn_exp2f(X[(i) + 1]); X[(i) + 2] = __builtin_amdgcn_exp2f(X[(i) + 2]); X[(i) + 3] = __builtin_amdgcn_exp2f(X[(i) + 3]); \
        sacc += a0; sacc += a1; sacc += a2; W0; PIN(X); PIN(PW); PIN(sacc); SBAR(); } while (0)
#define GAPA32(MF, a0, a1, a2, W0, W1, PW) do { MF; sacc += a0; sacc += a1; sacc += a2; W0; W1; PIN(PW); PIN(sacc); SBAR(); } while (0)
#define GAPA21(MF, a0, a1, W0, PW) do { MF; sacc += a0; sacc += a1; W0; PIN(PW); PIN(sacc); SBAR(); } while (0)
#define GAPB(MF, X, i) do { MF; X[i] = __builtin_amdgcn_exp2f(X[i]); X[(i) + 1] = __builtin_amdgcn_exp2f(X[(i) + 1]); PIN(X); SBAR(); } while (0)
#define STEP(C0, C1, P0, P1, t, GK, GV, GL) do { SBAR(); \
    const unsigned char* vp_ = vp0 + sl_prev * VSL; \
    float sacc = P0[0] + P0[1]; \
      \
    VRD(0); SBAR(); GAPX(C0 = MFMA32(kf[0], qr[0], zero16), P1, 0,  P0[2], P0[3], P0[4],    pw0[0] = PKW(P0, 0), pw0); \
    VRD(4); SBAR(); GAPX(C1 = MFMA32(kf[1], qr[0], zero16), P1, 4,  P0[5], P0[6], P0[7],    pw0[1] = PKW(P0, 2), pw0); \
    VRD(1); SBAR(); GAPX(C0 = MFMA32(kf[2], qr[1], C0),    P1, 8,  P0[8], P0[9], P0[10],   pw0[2] = PKW(P0, 4), pw0); \
    VRD(5); SBAR(); GAPX(C1 = MFMA32(kf[3], qr[1], C1),    P1, 12, P0[11], P0[12], P0[13], pw0[3] = PKW(P0, 6), pw0); \
    VRD(2); SBAR(); GAPA32(C0 = MFMA32(kf[4], qr[2], C0),  P0[14], P0[15], P1[0],  pw1[0] = PKW(P0, 8),  pw1[1] = PKW(P0, 10), pw1); \
    VRD(6); SBAR(); GAPA32(C1 = MFMA32(kf[5], qr[2], C1),  P1[1], P1[2], P1[3],    pw1[2] = PKW(P0, 12), pw1[3] = PKW(P0, 14), pw1); \
    VRD(3); SBAR(); GAPA32(C0 = MFMA32(kf[6], qr[3], C0),  P1[4], P1[5], P1[6],    pw2[0] = PKW(P1, 0),  pw2[1] = PKW(P1, 2),  pw2); \
    VRD(7); SBAR(); GAPA32(C1 = MFMA32(kf[7], qr[3], C1),  P1[7], P1[8], P1[9],    pw2[2] = PKW(P1, 4),  pw2[3] = PKW(P1, 6),  pw2); \
    GAPA21(C0 = MFMA32(kf[8], qr[4], C0),  P1[10], P1[11], pw3[0] = PKW(P1, 8),  pw3); \
    GAPA21(C1 = MFMA32(kf[9], qr[4], C1),  P1[12], P1[13], pw3[1] = PKW(P1, 10), pw3); \
    GAPA21(C0 = MFMA32(kf[10], qr[5], C0), P1[14], P1[15], pw3[2] = PKW(P1, 12), pw3); \
    GAPA21(C1 = MFMA32(kf[11], qr[5], C1), 0.f, 0.f,       pw3[3] = PKW(P1, 14), pw3); \
    l_reg += sacc; \
    if (GK) DMA_K((t) + 3, sl_cur); if (GV) DMA_V((t) + 1, sl_next); \
    SBAR(); \
    GAPB(o[0] = MFMA32(PAF(0), VFR(0), o[0]), C0, 0);              KRD(GL, 0); GAPB(o[1] = MFMA32(PAF(0), VFR(4), o[1]), C0, 2); \
    KRD(GL, 1); GAPB(o[0] = MFMA32(PAF(1), VFR(1), o[0]), C0, 4);  KRD(GL, 2); GAPB(o[1] = MFMA32(PAF(1), VFR(5), o[1]), C0, 6); \
    KRD(GL, 3); GAPB(o[0] = MFMA32(PAF(2), VFR(2), o[0]), C0, 8);  KRD(GL, 4); GAPB(o[1] = MFMA32(PAF(2), VFR(6), o[1]), C0, 10); \
    KRD(GL, 5); GAPB(o[0] = MFMA32(PAF(3), VFR(3), o[0]), C0, 12);             GAPB(o[1] = MFMA32(PAF(3), VFR(7), o[1]), C0, 14); \
    } while (0)
    int t = 1;
    for (; t + 5 < NT; t += 2) {
        STEP(pB0, pB1, pA0, pA1, t, true, true, true);     WAIT_BAR(3); ROT();
        STEP(pA0, pA1, pB0, pB1, t + 1, true, true, true); WAIT_BAR(3); ROT();
    }
#define ENDW(tt) do { if ((tt) + 3 < NT) { WAIT_BAR(3); } else if ((tt) + 2 < NT) { WAIT_BAR(1); } else { WAIT_BAR(0); } } while (0)
    for (; t + 1 < NT; t += 2) {
        STEP(pB0, pB1, pA0, pA1, t, (t + 3 < NT), (t + 1 < NT), (t + 1 < NT));         ENDW(t);     ROT();
        STEP(pA0, pA1, pB0, pB1, t + 1, (t + 4 < NT), (t + 2 < NT), (t + 2 < NT));     ENDW(t + 1); ROT();
    }
    STEP(pB0, pB1, pA0, pA1, NT - 1, false, false, false);
    { float sacc = 0.f;
#pragma unroll
      for (int r = 0; r < 16; ++r) pB1[r] = __builtin_amdgcn_exp2f(pB1[r]);
#pragma unroll
      for (int r = 0; r < 16; ++r) sacc += pB0[r] + pB1[r];
      l_reg += sacc;
      pw0 = (u32x4){PKW(pB0, 0), PKW(pB0, 2), PKW(pB0, 4), PKW(pB0, 6)}; pw1 = (u32x4){PKW(pB0, 8), PKW(pB0, 10), PKW(pB0, 12), PKW(pB0, 14)};
      pw2 = (u32x4){PKW(pB1, 0), PKW(pB1, 2), PKW(pB1, 4), PKW(pB1, 6)}; pw3 = (u32x4){PKW(pB1, 8), PKW(pB1, 10), PKW(pB1, 12), PKW(pB1, 14)};
      const unsigned char* vp_ = vp0 + sl_cur * VSL; _Pragma("unroll") for (int i = 0; i < 8; ++i) VRD(i);
      o[0] = MFMA32(PAF(0), VFR(0), o[0]); o[1] = MFMA32(PAF(0), VFR(4), o[1]); o[0] = MFMA32(PAF(1), VFR(1), o[0]); o[1] = MFMA32(PAF(1), VFR(5), o[1]);
      o[0] = MFMA32(PAF(2), VFR(2), o[0]); o[1] = MFMA32(PAF(2), VFR(6), o[1]); o[0] = MFMA32(PAF(3), VFR(3), o[0]); o[1] = MFMA32(PAF(3), VFR(7), o[1]); }
    asm volatile("s_waitcnt vmcnt(0) lgkmcnt(0)\n\ts_barrier" ::: "memory");
    { auto rr = __builtin_amdgcn_permlane32_swap(__float_as_uint(l_reg), __float_as_uint(l_reg), false, false); l_out = __uint_as_float(rr[0]) + __uint_as_float(rr[1]); }
#undef DMA_K
#undef DMA_V
#undef WAIT_BAR
#undef ROT
#undef KLOAD2
#undef QKT
#undef PKW
#undef PAF
#undef VRD
#undef VFR
#undef KRD
#undef GAPA
#undef GAPX
#undef GAPA32
#undef GAPA21
#undef GAPB
#undef STEP
#undef ENDW
}

DI void glds16(const void* g, unsigned lds_base) {
    unsigned sv; asm volatile("s_mov_b32 %0, m0\n\ts_mov_b32 m0, %2\n\ts_nop 0\n\tglobal_load_lds_dwordx4 %1, off\n\ts_mov_b32 m0, %0" : "=&s"(sv) : "v"(g), "s"(lds_base) : "memory"); }
#define MFMA16(a, b, c) __builtin_amdgcn_mfma_f32_16x16x32_bf16((a), (b), (c), 0, 0, 0)
DI void mla_core_x(const bf16_t* __restrict__ Qb, const bf16_t* __restrict__ Kb, const bf16_t* __restrict__ Vb, int nkeys, f32x4 (&o)[4][2], float (&l_out)[2], unsigned char* lds) {
    constexpr int ldq = 768, ldk = 768, ldv = 512, KSL = 12288, VSL = 8192, LDS_K = 0, LDS_V = 3 * KSL;
    const int tid = tid_l(), lane = tid & 63, c16 = lane & 15, g = lane >> 4; const int wid = __builtin_amdgcn_readfirstlane(tid >> 6);
    const int NT = nkeys / 64;
    LASP unsigned char* L3 = (LASP unsigned char*)lds;
    const bf16_t* ksrc0 = Kb + (size_t)lane * ldk + wid * 8;
    const bf16_t* ksrc1 = Kb + (size_t)lane * ldk + (8 + (wid & 3)) * 8;
    const bf16_t* vsrc = Vb + (size_t)(16 * (wid & 3) + (lane >> 2)) * ldv + (wid >> 2) * 32 + ((lane & 3) ^ (((lane >> 4) & 1) << 1)) * 8;
    const unsigned l3b = (unsigned)(uintptr_t)L3;
#define DMA_K(t, slot) do { glds16(ksrc0 + (size_t)(t) * 64 * ldk, l3b + LDS_K + (slot) * KSL + wid * 1024); \
                            glds16(ksrc1 + (size_t)(t) * 64 * ldk, l3b + LDS_K + (slot) * KSL + (8 + (wid & 3)) * 1024); } while (0)
#define DMA_V(t, slot) glds16(vsrc + (size_t)(t) * 64 * ldv, l3b + LDS_V + (slot) * VSL + wid * 1024)
#define WAIT_BAR(N) asm volatile("s_waitcnt vmcnt(" #N ") lgkmcnt(0)\n\ts_barrier" ::: "memory")
    const unsigned char* vpE = lds + LDS_V + (4 * g + (c16 >> 2)) * 64 + (g & 1) * 32 + (c16 & 3) * 8;
    const unsigned char* vpO = lds + LDS_V + (4 * g + (c16 >> 2)) * 64 + ((g & 1) ^ 1) * 32 + (c16 & 3) * 8;
    const unsigned char* kp0 = lds + LDS_K + g * 1024 + c16 * 16;
    DMA_K(0, 0); DMA_V(0, 0); DMA_K(1, 1);
    bf16x8 qf[2][3];
#pragma unroll
    for (int qb = 0; qb < 2; ++qb)
#pragma unroll
        for (int ks = 0; ks < 3; ++ks) qf[qb][ks] = *(const bf16x8*)(Qb + (size_t)(wid * 32 + qb * 16 + c16) * ldq + ks * 32 + g * 8);
    f32x4 la0 = {0.f, 0.f, 0.f, 0.f}, la1 = {0.f, 0.f, 0.f, 0.f};
    const short one_ = (c16 == 0) ? (short)0x3F80 : (short)0; const bf16x8 ones_a = {one_, one_, one_, one_, one_, one_, one_, one_};
#pragma unroll
    for (int d = 0; d < 4; ++d)
#pragma unroll
        for (int qb = 0; qb < 2; ++qb) o[d][qb] = (f32x4){0.f, 0.f, 0.f, 0.f};
    const f32x4 zero4 = {0.f, 0.f, 0.f, 0.f};
    f32x4 SA[4][2], SB[4][2]; bf16x8 kf[4][3]; s16x4 vlo[4][2], vhi[4][2]; u32x4 pw[2][2];
    int sl_prev = 0, sl_cur = 0, sl_next = 1;
#define ROT() do { sl_prev = sl_cur; sl_cur = sl_next; sl_next = (sl_next == 2) ? 0 : sl_next + 1; } while (0)
#define KLD(base, kb, ks) kf[kb][ks] = *(const bf16x8*)((base) + (ks) * 4096 + (kb) * 256)
#define KLOADALL(base) do { _Pragma("unroll") for (int ks_ = 0; ks_ < 3; ++ks_) { _Pragma("unroll") for (int kb_ = 0; kb_ < 4; ++kb_) KLD(base, kb_, ks_); } } while (0)
    DMA_K(2, 2);
    WAIT_BAR(5);
    KLOADALL(kp0);
#pragma unroll
    for (int kb = 0; kb < 4; ++kb)
#pragma unroll
        for (int qb = 0; qb < 2; ++qb) { SA[kb][qb] = MFMA16(kf[kb][0], qf[qb][0], zero4); SA[kb][qb] = MFMA16(kf[kb][1], qf[qb][1], SA[kb][qb]); SA[kb][qb] = MFMA16(kf[kb][2], qf[qb][2], SA[kb][qb]); }
#pragma unroll
    for (int kb = 0; kb < 2; ++kb)
#pragma unroll
        for (int qb = 0; qb < 2; ++qb)
#pragma unroll
            for (int i = 0; i < 4; ++i) SA[kb][qb][i] = __builtin_amdgcn_exp2f(SA[kb][qb][i]);
    WAIT_BAR(0);
    DMA_K(3, 0); DMA_V(1, 1); ROT();
    KLOADALL(kp0 + sl_cur * KSL);
    WAIT_BAR(3);
#define EX(X, kb, qb, i) X[kb][qb][i] = __builtin_amdgcn_exp2f(X[kb][qb][i])
#define VRD(d, s2) do { const unsigned char* b_ = (((d) & 1) ? vpO : vpE) + sl_prev * VSL + ((d) >> 1) * 4096 + (s2) * 2048; vlo[d][s2] = vtr_ld(b_); vhi[d][s2] = vtr_ld(b_ + 1024); } while (0)
#define VFR(d, s2) (bf16x8){vlo[d][s2][0], vlo[d][s2][1], vlo[d][s2][2], vlo[d][s2][3], vhi[d][s2][0], vhi[d][s2][1], vhi[d][s2][2], vhi[d][s2][3]}
#define PAF(s2, qb) __builtin_bit_cast(bf16x8, pw[s2][qb])
#define QK(C, ks, kb, qb) C[kb][qb] = MFMA16(kf[kb][ks], qf[qb][ks], C[kb][qb])
#define QK0(C, kb, qb) C[kb][qb] = MFMA16(kf[kb][0], qf[qb][0], zero4)
#define GA0(MF, Pp, kb, qb, i, d, s2) do { MF; EX(Pp, kb, qb, i); EX(Pp, kb, qb, (i) + 1); VRD(d, s2); PIN(Pp[kb][qb]); SBAR(); } while (0)
#define GA1(MF, Pp, kb, qb, i, s2, w) do { MF; pw[s2][qb][w] = cvtpk(Pp[kb][qb][i], Pp[kb][qb][(i) + 1]); PIN(pw[s2][qb]); SBAR(); } while (0)
#define LS(s2) do { la0 = MFMA16(ones_a, PAF(s2, 0), la0); la1 = MFMA16(ones_a, PAF(s2, 1), la1); SBAR(); } while (0)
#define GB(MF, C, kb, qb, i) do { MF; EX(C, kb, qb, i); PIN(C[kb][qb]); SBAR(); } while (0)
#define PV(d, s2, qb) o[d][qb] = MFMA16(VFR(d, s2), PAF(s2, qb), o[d][qb])
#define KRD(G, kb, ks) do { if (G) { KLD(kp0 + sl_next * KSL, kb, ks); SBAR(); } } while (0)
#define STEP(C, Pp, t, GK, GV, GL) do { SBAR(); \
    GA0(QK0(C, 0, 0), Pp, 2, 0, 0, 0, 0); GA0(QK0(C, 0, 1), Pp, 2, 0, 2, 1, 0); GA0(QK0(C, 1, 0), Pp, 2, 1, 0, 2, 0); GA0(QK0(C, 1, 1), Pp, 2, 1, 2, 3, 0); \
    GA0(QK0(C, 2, 0), Pp, 3, 0, 0, 0, 1); GA0(QK0(C, 2, 1), Pp, 3, 0, 2, 1, 1); GA0(QK0(C, 3, 0), Pp, 3, 1, 0, 2, 1); GA0(QK0(C, 3, 1), Pp, 3, 1, 2, 3, 1); \
    GA1(QK(C, 1, 0, 0), Pp, 0, 0, 0, 0, 0); GA1(QK(C, 1, 0, 1), Pp, 0, 0, 2, 0, 1); GA1(QK(C, 1, 1, 0), Pp, 1, 0, 0, 0, 2); GA1(QK(C, 1, 1, 1), Pp, 1, 0, 2, 0, 3); \
    GA1(QK(C, 1, 2, 0), Pp, 0, 1, 0, 0, 0); GA1(QK(C, 1, 2, 1), Pp, 0, 1, 2, 0, 1); GA1(QK(C, 1, 3, 0), Pp, 1, 1, 0, 0, 2); GA1(QK(C, 1, 3, 1), Pp, 1, 1, 2, 0, 3); \
    GA1(QK(C, 2, 0, 0), Pp, 2, 0, 0, 1, 0); GA1(QK(C, 2, 0, 1), Pp, 2, 0, 2, 1, 1); GA1(QK(C, 2, 1, 0), Pp, 3, 0, 0, 1, 2); GA1(QK(C, 2, 1, 1), Pp, 3, 0, 2, 1, 3); \
    GA1(QK(C, 2, 2, 0), Pp, 2, 1, 0, 1, 0); GA1(QK(C, 2, 2, 1), Pp, 2, 1, 2, 1, 1); GA1(QK(C, 2, 3, 0), Pp, 3, 1, 0, 1, 2); GA1(QK(C, 2, 3, 1), Pp, 3, 1, 2, 1, 3); \
    if (GK) DMA_K((t) + 3, sl_cur); if (GV) DMA_V((t) + 1, sl_next); \
    SBAR(); \
    GB(PV(0, 0, 0), C, 0, 0, 0); GB(PV(0, 0, 1), C, 0, 0, 1); KRD(GL, 0, 0); GB(PV(1, 0, 0), C, 0, 0, 2); KRD(GL, 1, 0); GB(PV(1, 0, 1), C, 0, 0, 3); KRD(GL, 2, 0); \
    GB(PV(2, 0, 0), C, 0, 1, 0); KRD(GL, 3, 0); GB(PV(2, 0, 1), C, 0, 1, 1); KRD(GL, 0, 1); GB(PV(3, 0, 0), C, 0, 1, 2); KRD(GL, 1, 1); GB(PV(3, 0, 1), C, 0, 1, 3); KRD(GL, 2, 1); \
    LS(0); GB(PV(0, 1, 0), C, 1, 0, 0); KRD(GL, 3, 1); GB(PV(0, 1, 1), C, 1, 0, 1); KRD(GL, 0, 2); GB(PV(1, 1, 0), C, 1, 0, 2); KRD(GL, 1, 2); GB(PV(1, 1, 1), C, 1, 0, 3); KRD(GL, 2, 2); \
    GB(PV(2, 1, 0), C, 1, 1, 0); KRD(GL, 3, 2); GB(PV(2, 1, 1), C, 1, 1, 1); GB(PV(3, 1, 0), C, 1, 1, 2); GB(PV(3, 1, 1), C, 1, 1, 3); LS(1); \
    } while (0)
    int t = 1;
    for (; t + 5 < NT; t += 2) {
        STEP(SB, SA, t, true, true, true);     WAIT_BAR(3); ROT();
        STEP(SA, SB, t + 1, true, true, true); WAIT_BAR(3); ROT();
    }
#define ENDW(tt) do { if ((tt) + 3 < NT) { WAIT_BAR(3); } else if ((tt) + 2 < NT) { WAIT_BAR(1); } else { WAIT_BAR(0); } } while (0)
    for (; t + 1 < NT; t += 2) {
        STEP(SB, SA, t, (t + 3 < NT), (t + 1 < NT), (t + 1 < NT));         ENDW(t);     ROT();
        STEP(SA, SB, t + 1, (t + 4 < NT), (t + 2 < NT), (t + 2 < NT));     ENDW(t + 1); ROT();
    }
    STEP(SB, SA, NT - 1, false, false, false);
    { sl_prev = sl_cur;
#pragma unroll
      for (int kb = 2; kb < 4; ++kb)
#pragma unroll
          for (int qb = 0; qb < 2; ++qb)
#pragma unroll
              for (int i = 0; i < 4; ++i) EX(SB, kb, qb, i);
#pragma unroll
      for (int s2 = 0; s2 < 2; ++s2)
#pragma unroll
          for (int qb = 0; qb < 2; ++qb) pw[s2][qb] = (u32x4){cvtpk(SB[2 * s2][qb][0], SB[2 * s2][qb][1]), cvtpk(SB[2 * s2][qb][2], SB[2 * s2][qb][3]), cvtpk(SB[2 * s2 + 1][qb][0], SB[2 * s2 + 1][qb][1]), cvtpk(SB[2 * s2 + 1][qb][2], SB[2 * s2 + 1][qb][3])};
#pragma unroll
      for (int s2 = 0; s2 < 2; ++s2)
#pragma unroll
          for (int d = 0; d < 4; ++d) VRD(d, s2);
#pragma unroll
      for (int s2 = 0; s2 < 2; ++s2)
#pragma unroll
          for (int d = 0; d < 4; ++d) { PV(d, s2, 0); PV(d, s2, 1); }
      LS(0); LS(1); }
    asm volatile("s_waitcnt vmcnt(0) lgkmcnt(0)\n\ts_barrier" ::: "memory");
    l_out[0] = __shfl(la0[0], c16); l_out[1] = __shfl(la1[0], c16);
#undef DMA_K
#undef DMA_V
#undef WAIT_BAR
#undef ROT
#undef KLD
#undef KLOADALL
#undef EX
#undef VRD
#undef VFR
#undef PAF
#undef QK
#undef QK0
#undef GA0
#undef GA1
#undef LS
#undef GB
#undef PV
#undef KRD
#undef STEP
#undef ENDW
}

template <int B> struct PVB2 {
    static constexpr int DVB = 2, D0 = B % DVB, KH = B / DVB;
    static DI void run(f32x16 (&oa)[2], f32x16 (&ob)[2], int vb, const bf16x8 (&paa)[4], const bf16x8 (&pab)[4], s16x4 (&cur)[4]) {
        constexpr int NB = 2 * DVB;
        s16x4 nxt[4];
        if constexpr (B + 1 < NB) { PVB<DVB, B + 1>::issue(vb, nxt); asm volatile("s_waitcnt lgkmcnt(4)" ::: "memory"); }
        else asm volatile("s_waitcnt lgkmcnt(0)" ::: "memory");
        __builtin_amdgcn_sched_barrier(0);
#define PKV(Lq, Hq) (bf16x8){Lq[0], Lq[1], Lq[2], Lq[3], Hq[0], Hq[1], Hq[2], Hq[3]}
        const bf16x8 v0 = PKV(cur[0], cur[1]), v1 = PKV(cur[2], cur[3]);
#undef PKV
        oa[D0] = MFMA32(paa[2 * KH], v0, oa[D0]); ob[D0] = MFMA32(pab[2 * KH], v0, ob[D0]);
        oa[D0] = MFMA32(paa[2 * KH + 1], v1, oa[D0]); ob[D0] = MFMA32(pab[2 * KH + 1], v1, ob[D0]);
        if constexpr (B + 1 < NB) PVB2<B + 1>::run(oa, ob, vb, paa, pab, nxt);
    }
};
DI void mla_core64(const bf16_t* __restrict__ Qb, const bf16_t* __restrict__ Kb, const bf16_t* __restrict__ Vb, int nkeys,
                   f32x16 (&oa)[2], f32x16 (&ob)[2], float& la_out, float& lb_out, unsigned char* lds) {
    constexpr int KS = 6, DVB = 2, ldq = 768, ldk = 768, ldv = 512;
    constexpr int KA = 8192, KBB = 4096, KTILE = KA + KBB, VTILE = 64 * DVB * 64, SLOT = KTILE + VTILE;
    const int tid = tid_l(), lane = tid & 63, wid = __builtin_amdgcn_readfirstlane(tid >> 6), r32_ = lane & 31, hi_ = lane >> 5;
    bf16x8 qa[KS], qb_[KS];
    { const bf16_t* Qw = Qb + (size_t)(wid * 64 + r32_) * ldq + hi_ * 8;
#pragma unroll
      for (int d0 = 0; d0 < KS; ++d0) { qa[d0] = *(const bf16x8*)(Qw + d0 * 16); qb_[d0] = *(const bf16x8*)(Qw + (size_t)32 * ldq + d0 * 16); } }
#pragma unroll
    for (int d = 0; d < DVB; ++d)
#pragma unroll
        for (int r = 0; r < 16; ++r) { oa[d][r] = 0.f; ob[d][r] = 0.f; }
    float la = 0.f, lb = 0.f;
    const f32x16 czero = {0.f, 0.f, 0.f, 0.f, 0.f, 0.f, 0.f, 0.f, 0.f, 0.f, 0.f, 0.f, 0.f, 0.f, 0.f, 0.f};
    int ksrc0, ksrc1, vsrc0;
    { const int p = wid * 64 + lane, row = p >> 3, slot = p & 7, ch = slot ^ ((row >> 1) & 7); ksrc0 = row * ldk + ch * 8; }
    { const int p = (wid & 3) * 64 + lane, row = p >> 2, slot = p & 3, ch = slot ^ ((row >> 2) & 3); ksrc1 = row * ldk + 64 + ch * 8; }
    { const int p = wid * 64 + lane, st = p >> 5, row8 = (p & 31) >> 2, piece = p & 3, kg_ = st / DVB, cb = st % DVB, kk = kg_ * 8 + row8;
      const int k = (kk & ~0xC) | ((kk & 4) << 1) | ((kk & 8) >> 1); vsrc0 = k * ldv + cb * 32 + piece * 8; }
    const bool kb_wave = wid < 4;
    constexpr int NSLOT = 6, PD = NSLOT - 1;
    const int NT = nkeys / 64;
    LASP unsigned char* L3 = (LASP unsigned char*)lds;
#define M_ISSUE(j) do { const int sl_ = ((j) % NSLOT) * SLOT; const bf16_t* kt_ = Kb + (size_t)(j) * 64 * ldk; const bf16_t* vt_ = Vb + (size_t)(j) * 64 * ldv; \
        __builtin_amdgcn_global_load_lds((const unsigned*)(kt_ + ksrc0), (LASP unsigned*)(L3 + sl_ + wid * 1024), 16, 0, 0); \
        if (kb_wave) __builtin_amdgcn_global_load_lds((const unsigned*)(kt_ + ksrc1), (LASP unsigned*)(L3 + sl_ + KA + (wid & 3) * 1024), 16, 0, 0); \
        __builtin_amdgcn_global_load_lds((const unsigned*)(vt_ + vsrc0), (LASP unsigned*)(L3 + sl_ + KTILE + wid * 1024), 16, 0, 0); } while (0)
#define M_WAIT1() do { if (kb_wave) asm volatile("s_waitcnt vmcnt(%0)" :: "n"((PD - 1) * 3) : "memory"); else asm volatile("s_waitcnt vmcnt(%0)" :: "n"((PD - 1) * 2) : "memory"); } while (0)
    const int vb0 = (int)(uintptr_t)(lds + KTILE) + v_rd_base(lane);
    M_ISSUE(0);
#pragma unroll
    for (int t = 1; t < PD; ++t) if (t < NT) M_ISSUE(t);
    if (NT >= PD) M_WAIT1(); else asm volatile("s_waitcnt vmcnt(0)" ::: "memory");
    __builtin_amdgcn_s_barrier();
    for (int j = 0; j < NT; ++j) {
        if (j + PD < NT) M_ISSUE(j + PD);
        const unsigned char* Kt = lds + (j % NSLOT) * SLOT;
        int r32 = r32_, hi = hi_; asm volatile("" : "+v"(r32), "+v"(hi));
        const int kax = (r32 >> 1) & 7, kbx = (r32 >> 2) & 3;
        f32x16 pa0_, pa1_, pb0_, pb1_;
        { const int off = ((hi ^ kax) << 4);
          const bf16x8 b0 = *(const bf16x8*)(Kt + r32 * 128 + off), b1 = *(const bf16x8*)(Kt + (32 + r32) * 128 + off);
          pa0_ = MFMA32(b0, qa[0], czero); pb0_ = MFMA32(b0, qb_[0], czero); pa1_ = MFMA32(b1, qa[0], czero); pb1_ = MFMA32(b1, qb_[0], czero); }
#pragma unroll
        for (int d0 = 1; d0 < 4; ++d0) { const int off = (((d0 * 2 + hi) ^ kax) << 4);
            const bf16x8 b0 = *(const bf16x8*)(Kt + r32 * 128 + off), b1 = *(const bf16x8*)(Kt + (32 + r32) * 128 + off);
            pa0_ = MFMA32(b0, qa[d0], pa0_); pb0_ = MFMA32(b0, qb_[d0], pb0_); pa1_ = MFMA32(b1, qa[d0], pa1_); pb1_ = MFMA32(b1, qb_[d0], pb1_); }
#pragma unroll
        for (int d0 = 4; d0 < 6; ++d0) { const int off = ((((d0 - 4) * 2 + hi) ^ kbx) << 4);
            const bf16x8 b0 = *(const bf16x8*)(Kt + KA + r32 * 64 + off), b1 = *(const bf16x8*)(Kt + KA + (32 + r32) * 64 + off);
            pa0_ = MFMA32(b0, qa[d0], pa0_); pb0_ = MFMA32(b0, qb_[d0], pb0_); pa1_ = MFMA32(b1, qa[d0], pa1_); pb1_ = MFMA32(b1, qb_[d0], pb1_); }
        const int vb = vb0 + (j % NSLOT) * SLOT;
        s16x4 tv0[4];
        __builtin_amdgcn_sched_barrier(0);
        PVB<DVB, 0>::issue(vb, tv0);
        bf16x8 paa[4], pab[4];
#define PK4(Pv, BASE, OUT) do { unsigned a0 = cvtpk(Pv[BASE + 0], Pv[BASE + 1]), a1 = cvtpk(Pv[BASE + 2], Pv[BASE + 3]);   \
    unsigned b0_ = cvtpk(Pv[BASE + 4], Pv[BASE + 5]), b1_ = cvtpk(Pv[BASE + 6], Pv[BASE + 7]);                              \
    auto r0 = __builtin_amdgcn_permlane32_swap(a0, b0_, false, false); auto r1 = __builtin_amdgcn_permlane32_swap(a1, b1_, false, false); \
    u32x4 w = {r0[0], r1[0], r0[1], r1[1]}; OUT = *reinterpret_cast<bf16x8*>(&w); } while (0)
        { float ps = 0.f;
#pragma unroll
          for (int r = 0; r < 16; ++r) { pa0_[r] = __builtin_amdgcn_exp2f(pa0_[r]); pa1_[r] = __builtin_amdgcn_exp2f(pa1_[r]); ps += pa0_[r] + pa1_[r]; }
          la += ps; PK4(pa0_, 0, paa[0]); PK4(pa0_, 8, paa[1]); PK4(pa1_, 0, paa[2]); PK4(pa1_, 8, paa[3]); }
        { float ps = 0.f;
#pragma unroll
          for (int r = 0; r < 16; ++r) { pb0_[r] = __builtin_amdgcn_exp2f(pb0_[r]); pb1_[r] = __builtin_amdgcn_exp2f(pb1_[r]); ps += pb0_[r] + pb1_[r]; }
          lb += ps; PK4(pb0_, 0, pab[0]); PK4(pb0_, 8, pab[1]); PK4(pb1_, 0, pab[2]); PK4(pb1_, 8, pab[3]); }
#undef PK4
        PVB2<0>::run(oa, ob, vb, paa, pab, tv0);
        if (j + PD < NT) M_WAIT1(); else asm volatile("s_waitcnt vmcnt(0)" ::: "memory");
        __builtin_amdgcn_s_barrier();
    }
#undef M_ISSUE
#undef M_WAIT1
    { auto rr = __builtin_amdgcn_permlane32_swap(__float_as_uint(la), __float_as_uint(la), false, false); la_out = __uint_as_float(rr[0]) + __uint_as_float(rr[1]); }
    { auto rr = __builtin_amdgcn_permlane32_swap(__float_as_uint(lb), __float_as_uint(lb), false, false); lb_out = __uint_as_float(rr[0]) + __uint_as_float(rr[1]); }
}
DI void mla_attn_unit64(const KP& P, int qb, int h, unsigned char* lds) {
    const bf16_t* Q = (const bf16_t*)((const unsigned char*)P.out + O_Q0);
    const bf16_t* K = (const bf16_t*)(P.ws + R_G);
    const bf16_t* V = (const bf16_t*)(P.ws + R_F);
    const int q0 = qb * 512;
    f32x16 oa[2], ob[2]; float la, lb;
    mla_core64(Q + (size_t)q0 * 768 + h * 96, K + h * 96, V + h * 64, T, oa, ob, la, lb, lds);
    const int tid = tid_l(), lane = tid & 63, wid = tid >> 6, r32 = lane & 31, hi = lane >> 5;
    bf16_t* CAT = (bf16_t*)(P.ws + R_H);
    float* li = (float*)(lds + 122880) + wid * 64;
    if (hi == 0) { li[r32] = 1.f / la; li[32 + r32] = 1.f / lb; }
    asm volatile("s_waitcnt lgkmcnt(0)" ::: "memory");
    __builtin_amdgcn_wave_barrier();
#pragma unroll
    for (int r = 0; r < 16; ++r) { const int rr = crow(r, hi); const float ia = li[rr], ib = li[32 + rr]; const size_t row = (size_t)q0 + wid * 64 + rr;
#pragma unroll
        for (int d = 0; d < 2; ++d) { CAT[row * 1024 + h * 64 + d * 32 + r32] = f2bf(oa[d][r] * ia); CAT[(row + 32) * 1024 + h * 64 + d * 32 + r32] = f2bf(ob[d][r] * ib); } }
    __syncthreads();
}

DI void mla_attn_unit(const KP& P, int qb, int h, unsigned char* lds) {
    const bf16_t* Q = (const bf16_t*)((const unsigned char*)P.out + O_Q0);
    const bf16_t* K = (const bf16_t*)(P.ws + R_G);
    const bf16_t* V = (const bf16_t*)(P.ws + R_F);
    const int q0 = qb * 256; const bool isctx = q0 >= L;
    const int key0 = isctx ? L : 0, nkeys = isctx ? NC : T;
    f32x4 o[4][2]; float l[2];
    mla_core_x(Q + (size_t)q0 * 768 + h * 96, K + (size_t)key0 * 768 + h * 96, V + (size_t)key0 * 512 + h * 64, nkeys, o, l, lds);
    const int tid = tid_l(), lane = tid & 63, wid = tid >> 6, c16 = lane & 15, g = lane >> 4;
    bf16_t* CAT = (bf16_t*)(P.ws + R_H);
#pragma unroll
    for (int qq = 0; qq < 2; ++qq) { const float inv = 1.f / l[qq]; const size_t row = (size_t)q0 + wid * 32 + qq * 16 + c16;
#pragma unroll
        for (int d = 0; d < 4; ++d) { u32x2 w; w.x = cvtpk(o[d][qq][0] * inv, o[d][qq][1] * inv); w.y = cvtpk(o[d][qq][2] * inv, o[d][qq][3] * inv);
            *(u32x2*)(CAT + row * 1024 + h * 64 + d * 16 + 4 * g) = w; } }
    __syncthreads();
}

DI void diff_core_hi(const bf16_t* __restrict__ Qb, const bf16_t* __restrict__ Kb, const bf16_t* __restrict__ Vb, int nkeys, f32x16 (&o)[4], float& l_out, unsigned char* lds) {
    constexpr int ldq = 1024, ldk = 1024, ldv = 512, KSL = 8192, VSL = 16384, LDS_K = 0, LDS_V = 3 * KSL;
    const int tid = tid_l(), lane = tid & 63, r32 = lane & 31, hi = lane >> 5; const int wid = __builtin_amdgcn_readfirstlane(tid >> 6);
    const int NT = nkeys / 64;
    LASP unsigned char* L3 = (LASP unsigned char*)lds;
    const bf16_t* ksrc = Kb + (size_t)lane * ldk + wid * 8;
    const bf16_t* vsrc0 = Vb + (size_t)(16 * (wid & 3) + (lane >> 2)) * ldv + (wid >> 2) * 32 + (lane & 3) * 8;
    const bf16_t* vsrc1 = vsrc0 + 64;
#define DMA_K(t, slot) __builtin_amdgcn_global_load_lds((const unsigned*)(ksrc + (size_t)(t) * 64 * ldk), (LASP unsigned*)(L3 + LDS_K + (slot) * KSL + wid * 1024), 16, 0, 0)
#define DMA_V(t, slot) do { __builtin_amdgcn_global_load_lds((const unsigned*)(vsrc0 + (size_t)(t) * 64 * ldv), (LASP unsigned*)(L3 + LDS_V + (slot) * VSL + wid * 1024), 16, 0, 0); \
                            __builtin_amdgcn_global_load_lds((const unsigned*)(vsrc1 + (size_t)(t) * 64 * ldv), (LASP unsigned*)(L3 + LDS_V + (slot) * VSL + (wid + 8) * 1024), 16, 0, 0); } while (0)
#define WAIT_BAR(N) asm volatile("s_waitcnt vmcnt(" #N ") lgkmcnt(0)\n\ts_barrier" ::: "memory")
    const unsigned char* vp0 = lds + LDS_V + ((lane >> 4) & 1) * 32 + (lane & 3) * 8 + (4 * hi + ((lane & 15) >> 2)) * 64;
    const unsigned char* kp0 = lds + LDS_K + hi * 1024 + r32 * 16;
    DMA_K(0, 0); DMA_V(0, 0); DMA_K(1, 1);
    bf16x8 qr[4];
#pragma unroll
    for (int d0 = 0; d0 < 4; ++d0) qr[d0] = *(const bf16x8*)(Qb + (size_t)(wid * 32 + r32) * ldq + d0 * 16 + hi * 8);
    float l_reg = 0.f;
#pragma unroll
    for (int d = 0; d < 4; ++d)
#pragma unroll
        for (int r = 0; r < 16; ++r) o[d][r] = 0.f;
    const f32x16 zero16 = {0.f, 0.f, 0.f, 0.f, 0.f, 0.f, 0.f, 0.f, 0.f, 0.f, 0.f, 0.f, 0.f, 0.f, 0.f, 0.f};
    f32x16 pA0, pA1, pB0, pB1; bf16x8 kf[8]; s16x4 vlo[8], vhi[8]; u32x4 pw0, pw1, pw2, pw3;
    int sl_prev = 0, sl_cur = 0, sl_next = 1;
#define ROT() do { sl_prev = sl_cur; sl_cur = sl_next; sl_next = (sl_next == 2) ? 0 : sl_next + 1; } while (0)
#define KLOAD2(base, d0) do { kf[2 * (d0)] = *(const bf16x8*)((base) + (d0) * 2048); kf[2 * (d0) + 1] = *(const bf16x8*)((base) + (d0) * 2048 + 512); } while (0)
    DMA_K(2, 2);
    WAIT_BAR(4);
    _Pragma("unroll") for (int d0 = 0; d0 < 4; ++d0) KLOAD2(kp0, d0);
    pA0 = MFMA32(kf[0], qr[0], zero16); pA1 = MFMA32(kf[1], qr[0], zero16); pA0 = MFMA32(kf[2], qr[1], pA0); pA1 = MFMA32(kf[3], qr[1], pA1);
    pA0 = MFMA32(kf[4], qr[2], pA0); pA1 = MFMA32(kf[5], qr[2], pA1); pA0 = MFMA32(kf[6], qr[3], pA0); pA1 = MFMA32(kf[7], qr[3], pA1);
#pragma unroll
    for (int r = 0; r < 16; ++r) { pA0[r] = __builtin_amdgcn_exp2f(pA0[r]); pA1[r] = __builtin_amdgcn_exp2f(pA1[r]); }
    WAIT_BAR(0);
    DMA_K(3, 0); DMA_V(1, 1); ROT();
    _Pragma("unroll") for (int d0 = 0; d0 < 4; ++d0) KLOAD2(kp0 + sl_cur * KSL, d0);
    WAIT_BAR(3);
#define PKW(Pv, i) cvtpk(Pv[i], Pv[(i) + 1])
#define PAF(k) __builtin_bit_cast(bf16x8, pw##k)
#define VSL_(d0, ks) ((((ks) & 1) << 2) + (d0))
#define VRD(d0, ks) do { vlo[VSL_(d0, ks)] = vtr_ld(vp_ + (d0) * 4096 + (ks) * 1024); vhi[VSL_(d0, ks)] = vtr_ld(vp_ + (d0) * 4096 + (ks) * 1024 + 512); } while (0)
#define VFR2(d0, ks) (bf16x8){vlo[VSL_(d0, ks)][0], vlo[VSL_(d0, ks)][1], vlo[VSL_(d0, ks)][2], vlo[VSL_(d0, ks)][3], vhi[VSL_(d0, ks)][0], vhi[VSL_(d0, ks)][1], vhi[VSL_(d0, ks)][2], vhi[VSL_(d0, ks)][3]}
#define KRD(G, d0) do { if (G) { KLOAD2(kp0 + sl_next * KSL, d0); SBAR(); } } while (0)
#define GAPA(MF, a0, a1, a2, a3, W0, W1, PW) do { MF; sacc += a0; sacc += a1; sacc += a2; sacc += a3; W0; W1; PIN(PW); PIN(sacc); SBAR(); } while (0)
#define GAPB(d0, ks, X, i, NEXTRD) do { \
        o[d0] = MFMA32(PAF(ks), VFR2(d0, ks), o[d0]); X[i] = __builtin_amdgcn_exp2f(X[i]); X[(i) + 1] = __builtin_amdgcn_exp2f(X[(i) + 1]); PIN(X); SBAR(); } while (0)
#define STEP(C0, C1, P0, P1, t, GK, GV, GL) do { SBAR(); \
    const unsigned char* vp_ = vp0 + LDS_V - LDS_V + sl_prev * VSL; \
    float sacc = P0[0] + P0[1]; \
    VRD(0, 0); SBAR(); GAPA(C0 = MFMA32(kf[0], qr[0], zero16), P0[2], P0[3], P0[4], P0[5],     pw0[0] = PKW(P0, 0),  pw0[1] = PKW(P0, 2),  pw0); \
    VRD(1, 0); SBAR(); GAPA(C1 = MFMA32(kf[1], qr[0], zero16), P0[6], P0[7], P0[8], P0[9],     pw0[2] = PKW(P0, 4),  pw0[3] = PKW(P0, 6),  pw0); \
    VRD(2, 0); SBAR(); GAPA(C0 = MFMA32(kf[2], qr[1], C0),    P0[10], P0[11], P0[12], P0[13], pw1[0] = PKW(P0, 8),  pw1[1] = PKW(P0, 10), pw1); \
    VRD(3, 0); SBAR(); GAPA(C1 = MFMA32(kf[3], qr[1], C1),    P0[14], P0[15], P1[0], P1[1],   pw1[2] = PKW(P0, 12), pw1[3] = PKW(P0, 14), pw1); \
    VRD(0, 1); SBAR(); GAPA(C0 = MFMA32(kf[4], qr[2], C0),    P1[2], P1[3], P1[4], P1[5],     pw2[0] = PKW(P1, 0),  pw2[1] = PKW(P1, 2),  pw2); \
    VRD(1, 1); SBAR(); GAPA(C1 = MFMA32(kf[5], qr[2], C1),    P1[6], P1[7], P1[8], P1[9],     pw2[2] = PKW(P1, 4),  pw2[3] = PKW(P1, 6),  pw2); \
    VRD(2, 1); SBAR(); GAPA(C0 = MFMA32(kf[6], qr[3], C0),    P1[10], P1[11], P1[12], P1[13], pw3[0] = PKW(P1, 8),  pw3[1] = PKW(P1, 10), pw3); \
    VRD(3, 1); SBAR(); GAPA(C1 = MFMA32(kf[7], qr[3], C1),    P1[14], P1[15], 0.f, 0.f,       pw3[2] = PKW(P1, 12), pw3[3] = PKW(P1, 14), pw3); \
    l_reg += sacc; \
    if (GK) DMA_K((t) + 3, sl_cur); if (GV) DMA_V((t) + 1, sl_next); \
    SBAR(); \
      \
    GAPB(0, 0, C0, 0, 6);  VRD(0, 2); SBAR(); GAPB(1, 0, C0, 2, 6);  VRD(1, 2); SBAR(); GAPB(2, 0, C0, 4, 6);  VRD(2, 2); SBAR(); GAPB(3, 0, C0, 6, 6);  VRD(3, 2); SBAR(); \
    KRD(GL, 0); GAPB(0, 1, C0, 8, 6);  VRD(0, 3); SBAR(); GAPB(1, 1, C0, 10, 6); VRD(1, 3); SBAR(); GAPB(2, 1, C0, 12, 6); VRD(2, 3); SBAR(); GAPB(3, 1, C0, 14, 6); VRD(3, 3); SBAR(); \
    KRD(GL, 1); GAPB(0, 2, C1, 0, 6);  GAPB(1, 2, C1, 2, 6);  KRD(GL, 2); GAPB(2, 2, C1, 4, 6);  GAPB(3, 2, C1, 6, 6); \
    KRD(GL, 3); GAPB(0, 3, C1, 8, 6);  GAPB(1, 3, C1, 10, 4); GAPB(2, 3, C1, 12, 2); GAPB(3, 3, C1, 14, 0); \
    } while (0)
    int t = 1;
    for (; t + 5 < NT; t += 2) {
        STEP(pB0, pB1, pA0, pA1, t, true, true, true);     WAIT_BAR(3); ROT();
        STEP(pA0, pA1, pB0, pB1, t + 1, true, true, true); WAIT_BAR(3); ROT();
    }
#define ENDW(tt) do { if ((tt) + 3 < NT) { WAIT_BAR(3); } else if ((tt) + 2 < NT) { WAIT_BAR(2); } else { WAIT_BAR(0); } } while (0)
    for (; t + 1 < NT; t += 2) {
        STEP(pB0, pB1, pA0, pA1, t, (t + 3 < NT), (t + 1 < NT), (t + 1 < NT));         ENDW(t);     ROT();
        STEP(pA0, pA1, pB0, pB1, t + 1, (t + 4 < NT), (t + 2 < NT), (t + 2 < NT));     ENDW(t + 1); ROT();
    }
    STEP(pB0, pB1, pA0, pA1, NT - 1, false, false, false);
    { float sacc = 0.f;
#pragma unroll
      for (int r = 0; r < 16; ++r) sacc += pB0[r] + pB1[r];
      l_reg += sacc;
      pw0 = (u32x4){PKW(pB0, 0), PKW(pB0, 2), PKW(pB0, 4), PKW(pB0, 6)}; pw1 = (u32x4){PKW(pB0, 8), PKW(pB0, 10), PKW(pB0, 12), PKW(pB0, 14)};
      pw2 = (u32x4){PKW(pB1, 0), PKW(pB1, 2), PKW(pB1, 4), PKW(pB1, 6)}; pw3 = (u32x4){PKW(pB1, 8), PKW(pB1, 10), PKW(pB1, 12), PKW(pB1, 14)};
      const unsigned char* vp_ = vp0 + sl_cur * VSL;
#define DRAIN(ks) do { VRD(0, ks); VRD(1, ks); VRD(2, ks); VRD(3, ks); SBAR(); \
        o[0] = MFMA32(PAF(ks), VFR2(0, ks), o[0]); o[1] = MFMA32(PAF(ks), VFR2(1, ks), o[1]); o[2] = MFMA32(PAF(ks), VFR2(2, ks), o[2]); o[3] = MFMA32(PAF(ks), VFR2(3, ks), o[3]); SBAR(); } while (0)
      DRAIN(0); DRAIN(1); DRAIN(2); DRAIN(3);
#undef DRAIN
    }
    asm volatile("s_waitcnt vmcnt(0) lgkmcnt(0)\n\ts_barrier" ::: "memory");
    { auto rr = __builtin_amdgcn_permlane32_swap(__float_as_uint(l_reg), __float_as_uint(l_reg), false, false); l_out = __uint_as_float(rr[0]) + __uint_as_float(rr[1]); }
#undef DMA_K
#undef DMA_V
#undef WAIT_BAR
#undef ROT
#undef KLOAD2
#undef PKW
#undef PAF
#undef VRD
#undef VFR2
#undef VSL_
#undef KRD
#undef GAPA
#undef GAPB
#undef STEP
#undef ENDW
}

DI void diff_attn_unit(const KP& P, int qb, int h, unsigned char* lds) {
    const int q0 = qb * 256;
#pragma unroll 1
    for (int mp = 0; mp < 2; ++mp) {
        f32x16 o[4]; float l;
        { const bf16_t* QK = (const bf16_t*)(P.ws + R1_QK); const bf16_t* V = (const bf16_t*)(P.ws + R1_V);
          diff_core_hi(QK + (size_t)q0 * 1024 + h * 128 + mp * 64, QK + 512 + h * 128 + mp * 64, V + h * 128, T, o, l, lds); }
        const int tid = tid_l(), lane = tid & 63, wid = tid >> 6, r32 = lane & 31, hi = lane >> 5;
        bf16_t* CAT = (bf16_t*)(P.ws + R_H);
        float* li = (float*)(lds + 122880) + wid * 32;
        if (hi == 0) li[r32] = 1.f / l;
        asm volatile("s_waitcnt lgkmcnt(0)" ::: "memory");
        __builtin_amdgcn_wave_barrier();
        if (mp == 0) {
#pragma unroll
            for (int r = 0; r < 16; ++r) { const int rr = crow(r, hi); const float inv = li[rr]; const size_t row = (size_t)q0 + wid * 32 + rr;
#pragma unroll
                for (int d = 0; d < 4; ++d) CAT[row * 1024 + h * 128 + d * 32 + r32] = f2bf(o[d][r] * inv); }
        } else {
            const float lam = ((const float*)(P.ws + M_CONST))[2]; const float* g_o = P.in[35];
#pragma unroll
            for (int r = 0; r < 16; ++r) { const int rr = crow(r, hi); const float inv = li[rr]; const size_t row = (size_t)q0 + wid * 32 + rr;
                float dv[4]; float ss = 0.f;
#pragma unroll
                for (int d = 0; d < 4; ++d) { const float o1 = bf2f(CAT[row * 1024 + h * 128 + d * 32 + r32]); dv[d] = o1 - lam * o[d][r] * inv; ss += dv[d] * dv[d]; }
#pragma unroll
                for (int s_ = 1; s_ < 32; s_ <<= 1) ss += __shfl_xor(ss, s_);
                const float rstd = rsqrtf(ss * (1.f / 128.f) + EPS) * (1.f - LAM_INIT);
#pragma unroll
                for (int d = 0; d < 4; ++d) CAT[row * 1024 + h * 128 + d * 32 + r32] = f2bf(dv[d] * rstd * g_o[d * 32 + r32]); }
        }
        __syncthreads();
    }
}

DI void p0_ada_item(const KP& P, int item, unsigned char* lds) {
    const int layer = item / 96, cgp = item % 96, tid = threadIdx.x, col = tid & 63, ks = tid >> 6;
    const float* W = P.in[4] + (size_t)layer * 1024 * 6144 + cgp * 64 + col;
    const float* c = P.in[1]; const float* cc = P.in[3];
    float a0 = 0.f, a1 = 0.f;
#pragma unroll 32
    for (int k = ks * 128; k < ks * 128 + 128; ++k) { const float w = W[(size_t)k * 6144]; a0 += silu_f(c[k]) * w; a1 += silu_f(cc[k]) * w; }
    float* red = (float*)lds;
    red[(ks * 64 + col) * 2] = a0; red[(ks * 64 + col) * 2 + 1] = a1;
    __syncthreads();
    if (tid < 128) { const int cl = tid & 63, which = tid >> 6; float s = 0.f;
#pragma unroll
        for (int q = 0; q < 8; ++q) s += red[(q * 64 + cl) * 2 + which];
        const int n = cgp * 64 + cl;
        ((float*)(P.ws + M_MODS))[(layer * 2 + which) * 6144 + n] = s + P.in[5][layer * 6144 + n]; }
    __syncthreads();
}
DI void p0_transpose_item(const float* W, int K, int N, bf16_t* WT, int item, float* scr, int lane, int mode) {
    const int nblk = (N + 31) / 32, kb = item / nblk, nb = item % nblk, k0 = 64 * kb, n0 = 32 * nb;
    const bool nok = n0 + (lane & 31) < N;
#pragma unroll
    for (int i = 0; i < 32; ++i) { const int kk = 2 * i + (lane >> 5); scr[kk * 33 + (lane & 31)] = nok ? W[(size_t)(k0 + kk) * N + n0 + (lane & 31)] : 0.f; }
    asm volatile("s_waitcnt lgkmcnt(0)" ::: "memory"); __builtin_amdgcn_wave_barrier();
    const int c = lane & 7;
#pragma unroll
    for (int j = 0; j < 4; ++j) { const int n = (lane >> 3) + 8 * j; const float* s = scr + (8 * c) * 33 + n;
        u32x4 ov; ov.x = cvtpk(s[0 * 33], s[1 * 33]); ov.y = cvtpk(s[2 * 33], s[3 * 33]); ov.z = cvtpk(s[4 * 33], s[5 * 33]); ov.w = cvtpk(s[6 * 33], s[7 * 33]);
        int nn = n0 + n;
        if (mode == 1) nn = (nn >> 7) * 256 + (nn & 127);
        else if (mode == 2) nn = (nn >> 7) * 256 + 128 + (nn & 127);
        if (n0 + n < N) *(u32x4*)(WT + (size_t)nn * K + k0 + 8 * c) = ov; }
    asm volatile("s_waitcnt lgkmcnt(0)" ::: "memory"); __builtin_amdgcn_wave_barrier();
}
DI void p0_wmat(const float* W, bf16_t* WT, int K, int N, int mode, int& base, float* scr, int lane, int gw, int NGW) {
    const int ni = (K / 64) * ((N + 31) / 32);
    int i = gw; if (i < base) i += ((base - i + NGW - 1) / NGW) * NGW;
    for (; i < base + ni; i += NGW) p0_transpose_item(W, K, N, WT, i - base, scr, lane, mode);
    base += ni;
}
DI void p0_weights(const KP& P, unsigned char* lds, int gw, int NGW, int part) {
    const int lane = tid_l() & 63, wid = tid_l() >> 6;
    float* scr = (float*)(lds + 8192) + wid * (64 * 33);
    unsigned char* ws = P.ws;
    int base = 0;
    if (part == 0) {
    p0_wmat(P.in[9], (bf16_t*)(ws + W_IN0), 1024, 1184, 0, base, scr, lane, gw, NGW);
    p0_wmat(P.in[12], (bf16_t*)(ws + W_QB), 384, 768, 0, base, scr, lane, gw, NGW);
    p0_wmat(P.in[14], (bf16_t*)(ws + W_KVB), 256, 1024, 0, base, scr, lane, gw, NGW);
    p0_wmat(P.in[25], (bf16_t*)(ws + W_GLU), 512, 512, 0, base, scr, lane, gw, NGW);
    p0_wmat(P.in[10], (bf16_t*)(ws + W_OUT0), 1024, 1024, 0, base, scr, lane, gw, NGW);
    p0_wmat(P.in[6], (bf16_t*)(ws + W_13_0), 1024, 2816, 1, base, scr, lane, gw, NGW);
    p0_wmat(P.in[7], (bf16_t*)(ws + W_13_0), 1024, 2816, 2, base, scr, lane, gw, NGW);
    p0_wmat(P.in[8], (bf16_t*)(ws + W_2_0), 2816, 1024, 0, base, scr, lane, gw, NGW);
    p0_wmat(P.in[27], (bf16_t*)(ws + W_IN1), 1024, 3088, 0, base, scr, lane, gw, NGW);
    } else {
    p0_wmat(P.in[28], (bf16_t*)(ws + W_OUT1), 1024, 1024, 0, base, scr, lane, gw, NGW);
    p0_wmat(P.in[6] + (size_t)1024 * 2816, (bf16_t*)(ws + W_13_1), 1024, 2816, 1, base, scr, lane, gw, NGW);
    p0_wmat(P.in[7] + (size_t)1024 * 2816, (bf16_t*)(ws + W_13_1), 1024, 2816, 2, base, scr, lane, gw, NGW);
    p0_wmat(P.in[8] + (size_t)2816 * 1024, (bf16_t*)(ws + W_2_1), 2816, 1024, 0, base, scr, lane, gw, NGW);
    }
}
DI void p0_s5_tables(const KP& P, int item, unsigned char* lds) {
    const int d = item >> 5, g = item & 31, tid = threadIdx.x;
    float* apw = (float*)lds;
    float* bbs = apw + 33 * 64 * 2;
    float* Cs = bbs + 64 * 16 * 2;
    const int dg = d * 32 + g;
    if (tid < 64) {
        const int n = tid;
        const float dt = expf(P.in[19][dg]);
        const float lr = P.in[17][dg * 64 + n], li = P.in[18][dg * 64 + n];
        const float mag = expf(lr * dt), ang = li * dt;
        const float ar = mag * cosf(ang), ai = mag * sinf(ang);
        const float den = lr * lr + li * li;
        const float kr = ((ar - 1.f) * lr + ai * li) / den, ki = (ai * lr - (ar - 1.f) * li) / den;
        float pr = 1.f, pi = 0.f;
        for (int t = 0; t <= 32; ++t) { apw[(t * 64 + n) * 2] = pr; apw[(t * 64 + n) * 2 + 1] = pi; const float nr = pr * ar - pi * ai, ni = pr * ai + pi * ar; pr = nr; pi = ni; }
        for (int c = 0; c < 16; ++c) { const float br = P.in[20][(dg * 64 + n) * 16 + c], bi = P.in[21][(dg * 64 + n) * 16 + c];
            bbs[(n * 16 + c) * 2] = kr * br - ki * bi; bbs[(n * 16 + c) * 2 + 1] = kr * bi + ki * br; }
    }
    for (int i = tid; i < 1024; i += NTHREADS) { Cs[i * 2] = P.in[22][dg * 1024 + i]; Cs[i * 2 + 1] = P.in[23][dg * 1024 + i]; }
    __syncthreads();
    float* APOW = (float*)(P.ws + M_APOW) + (size_t)dg * 33 * 64 * 2;
    float* BB = (float*)(P.ws + M_BB) + (size_t)dg * 64 * 16 * 2;
    float* KT = (float*)(P.ws + M_KT) + (size_t)dg * 32 * 256;
    for (int i = tid; i < 33 * 64 * 2; i += NTHREADS) APOW[i] = apw[i];
    for (int i = tid; i < 64 * 16 * 2; i += NTHREADS) BB[i] = bbs[i];
    for (int i = tid; i < 32 * 256; i += NTHREADS) {
        const int tau = i >> 8, c = (i >> 4) & 15, cp = i & 15; float s = 0.f;
        for (int n = 0; n < 64; ++n) {
            const float cr = Cs[(c * 64 + n) * 2], ci = Cs[(c * 64 + n) * 2 + 1], pr = apw[(tau * 64 + n) * 2], pi = apw[(tau * 64 + n) * 2 + 1];
            const float br = bbs[(n * 16 + cp) * 2], bi = bbs[(n * 16 + cp) * 2 + 1];
            const float zr = cr * pr - ci * pi, zi = cr * pi + ci * pr;
            s += zr * br - zi * bi;
        }
        KT[i] = s;
    }
    __syncthreads();
}
DI void p0_consts(const KP& P) {
    const int tid = threadIdx.x;
    float* R16 = (float*)(P.ws + M_ROPE16); float* R8 = (float*)(P.ws + M_ROPE8);
    for (int i = tid; i < 256 * 16; i += NTHREADS) { const int pos = i >> 4, f = i & 15; const float inv = exp2f(-(float)f * (1.f / 16.f) * 13.287712379549449f);
        const float ang = (float)pos * inv; R16[i * 2] = cosf(ang); R16[i * 2 + 1] = sinf(ang); }
    for (int i = tid; i < 256 * 8; i += NTHREADS) { const int pos = i >> 3, f = i & 7; const float inv = exp2f(-(float)f * (1.f / 8.f) * 13.287712379549449f);
        const float ang = (float)pos * inv; R8[i * 2] = cosf(ang); R8[i * 2 + 1] = sinf(ang); }
    if (tid == 0) {
        float* cst = (float*)(P.ws + M_CONST);
        float mq = 0.f, mk = 0.f; for (int i = 0; i < 96; ++i) { mq = fmaxf(mq, fabsf(P.in[15][i])); mk = fmaxf(mk, fabsf(P.in[16][i])); }
        cst[0] = mq * mk * 9.797958971132712f * LOG2E;
        mq = 0.f; mk = 0.f; for (int i = 0; i < 64; ++i) { mq = fmaxf(mq, fabsf(P.in[29][i])); mk = fmaxf(mk, fabsf(P.in[30][i])); }
        cst[1] = mq * mk * 8.f * LOG2E;
        float s1 = 0.f, s2 = 0.f; for (int i = 0; i < 64; ++i) { s1 += P.in[31][i] * P.in[32][i]; s2 += P.in[33][i] * P.in[34][i]; }
        cst[2] = expf(s1) - expf(s2) + LAM_INIT;
    }
}

DI void modulate_rows(const KP& P, const float* xlat, const float* xctx, int layer, int shift_idx, int nrows, int gw_, int NGW) {
    const int lane = tid_l() & 63;
    bf16_t* __restrict__ H = (bf16_t*)(P.ws + R_A);
    const float* mods = (const float*)(P.ws + M_MODS);
    for (int row0 = gw_; row0 < nrows; row0 += 2 * NGW) {
        const int row1 = row0 + NGW; const bool has1 = row1 < nrows;
        const int r1 = has1 ? row1 : row0;
        const float* __restrict__ s0 = row0 < L ? xlat + (size_t)row0 * 1024 : xctx + (size_t)(row0 - L) * 1024;
        const float* __restrict__ s1 = r1 < L ? xlat + (size_t)r1 * 1024 : xctx + (size_t)(r1 - L) * 1024;
        f32x4 v0[4], v1[4];
#pragma unroll
        for (int j = 0; j < 4; ++j) { v0[j] = *(const f32x4*)(s0 + 4 * lane + 256 * j); v1[j] = *(const f32x4*)(s1 + 4 * lane + 256 * j); }
        float ss0 = 0.f, ss1 = 0.f;
#pragma unroll
        for (int j = 0; j < 4; ++j) { ss0 += v0[j].x * v0[j].x + v0[j].y * v0[j].y + v0[j].z * v0[j].z + v0[j].w * v0[j].w; ss1 += v1[j].x * v1[j].x + v1[j].y * v1[j].y + v1[j].z * v1[j].z + v1[j].w * v1[j].w; }
        const float rstd0 = rsqrtf(wave_sum(ss0) * (1.f / 1024.f) + EPS), rstd1 = rsqrtf(wave_sum(ss1) * (1.f / 1024.f) + EPS);
        const float* md0 = mods + (layer * 2 + (row0 < L ? 0 : 1)) * 6144; const float* md1 = mods + (layer * 2 + (r1 < L ? 0 : 1)) * 6144;
#pragma unroll
        for (int j = 0; j < 4; ++j) { const int c = 4 * lane + 256 * j;
            { const f32x4 sh = *(const f32x4*)(md0 + shift_idx * 1024 + c), sc = *(const f32x4*)(md0 + (shift_idx + 1) * 1024 + c);
              u32x2 w; w.x = cvtpk(v0[j].x * rstd0 * (1.f + sc.x) + sh.x, v0[j].y * rstd0 * (1.f + sc.y) + sh.y); w.y = cvtpk(v0[j].z * rstd0 * (1.f + sc.z) + sh.z, v0[j].w * rstd0 * (1.f + sc.w) + sh.w);
              *(u32x2*)(H + (size_t)row0 * 1024 + c) = w; }
            if (has1) { const f32x4 sh = *(const f32x4*)(md1 + shift_idx * 1024 + c), sc = *(const f32x4*)(md1 + (shift_idx + 1) * 1024 + c);
              u32x2 w; w.x = cvtpk(v1[j].x * rstd1 * (1.f + sc.x) + sh.x, v1[j].y * rstd1 * (1.f + sc.y) + sh.y); w.y = cvtpk(v1[j].z * rstd1 * (1.f + sc.z) + sh.z, v1[j].w * rstd1 * (1.f + sc.w) + sh.w);
              *(u32x2*)(H + (size_t)row1 * 1024 + c) = w; } }
    }
}
DI void p3_norm_rows(const KP& P, int gw_, int NGW) {
    const int lane = tid_l() & 63;
    bf16_t* Z0 = (bf16_t*)(P.ws + R_B);
    float gq[6], gk[4];
#pragma unroll
    for (int e = 0; e < 6; ++e) gq[e] = P.in[11][6 * lane + e];
#pragma unroll
    for (int e = 0; e < 4; ++e) gk[e] = P.in[13][4 * lane + e];
    for (int row0 = gw_; row0 < T; row0 += 2 * NGW) {
        const int row1 = row0 + NGW; const bool has1 = row1 < T; const int r1 = has1 ? row1 : row0;
        unsigned* q0p = (unsigned*)(Z0 + (size_t)row0 * 672 + 6 * lane); unsigned* q1p = (unsigned*)(Z0 + (size_t)r1 * 672 + 6 * lane);
        u32x2* k0p = (u32x2*)(Z0 + (size_t)row0 * 672 + 384 + 4 * lane); u32x2* k1p = (u32x2*)(Z0 + (size_t)r1 * 672 + 384 + 4 * lane);
        unsigned a0[3], a1[3]; u32x2 b0, b1;
#pragma unroll
        for (int e = 0; e < 3; ++e) { a0[e] = q0p[e]; a1[e] = q1p[e]; }
        b0 = *k0p; b1 = *k1p;
        float q0[6], q1[6], k0[4], k1[4];
#pragma unroll
        for (int e = 0; e < 3; ++e) { q0[2 * e] = bflo(a0[e]); q0[2 * e + 1] = bfhi(a0[e]); q1[2 * e] = bflo(a1[e]); q1[2 * e + 1] = bfhi(a1[e]); }
        k0[0] = bflo(b0.x); k0[1] = bfhi(b0.x); k0[2] = bflo(b0.y); k0[3] = bfhi(b0.y);
        k1[0] = bflo(b1.x); k1[1] = bfhi(b1.x); k1[2] = bflo(b1.y); k1[3] = bfhi(b1.y);
        float sq0 = 0.f, sq1 = 0.f, sk0 = 0.f, sk1 = 0.f;
#pragma unroll
        for (int e = 0; e < 6; ++e) { sq0 += q0[e] * q0[e]; sq1 += q1[e] * q1[e]; }
#pragma unroll
        for (int e = 0; e < 4; ++e) { sk0 += k0[e] * k0[e]; sk1 += k1[e] * k1[e]; }
        const float rq0 = rsqrtf(wave_sum(sq0) * (1.f / 384.f) + EPS), rq1 = rsqrtf(wave_sum(sq1) * (1.f / 384.f) + EPS);
        const float rk0 = rsqrtf(wave_sum(sk0) * (1.f / 256.f) + EPS), rk1 = rsqrtf(wave_sum(sk1) * (1.f / 256.f) + EPS);
#pragma unroll
        for (int e = 0; e < 3; ++e) q0p[e] = cvtpk(q0[2 * e] * rq0 * gq[2 * e], q0[2 * e + 1] * rq0 * gq[2 * e + 1]);
        { u32x2 w; w.x = cvtpk(k0[0] * rk0 * gk[0], k0[1] * rk0 * gk[1]); w.y = cvtpk(k0[2] * rk0 * gk[2], k0[3] * rk0 * gk[3]); *k0p = w; }
        if (has1) {
#pragma unroll
            for (int e = 0; e < 3; ++e) q1p[e] = cvtpk(q1[2 * e] * rq1 * gq[2 * e], q1[2 * e + 1] * rq1 * gq[2 * e + 1]);
            u32x2 w; w.x = cvtpk(k1[0] * rk1 * gk[0], k1[1] * rk1 * gk[1]); w.y = cvtpk(k1[2] * rk1 * gk[2], k1[3] * rk1 * gk[3]); *k1p = w; }
    }
}
DI void p5_finalize_rows(const KP& P, int gw, int NGW) {
    const int lane = tid_l() & 63;
    bf16_t* Q0 = (bf16_t*)((unsigned char*)P.out + O_Q0);
    const bf16_t* KN = (const bf16_t*)((const unsigned char*)P.out + O_KN);
    const bf16_t* Z0 = (const bf16_t*)(P.ws + R_B);
    bf16_t* K0 = (bf16_t*)(P.ws + R_G);
    const float* R8 = (const float*)(P.ws + M_ROPE8);
    const float* gqn = P.in[15]; const float* gkn = P.in[16];
    const int h = lane / 6, j = lane % 6; const bool act = lane < 48;
    const float qscale = 0.10206207261596577f * LOG2E;
    for (int row = gw; row < T; row += NGW) {
        const bool lat = row < L; const int prow = (row >> 6) & 255, pcol = row & 63;
        float q[16], k[16]; float sq = 0.f, sk = 0.f;
        if (act) {
            const u32x4 a = *(const u32x4*)(Q0 + (size_t)row * 768 + h * 96 + j * 16), b = *(const u32x4*)(Q0 + (size_t)row * 768 + h * 96 + j * 16 + 8);
            const unsigned wq[8] = {a.x, a.y, a.z, a.w, b.x, b.y, b.z, b.w};
#pragma unroll
            for (int i = 0; i < 8; ++i) { q[2 * i] = bflo(wq[i]); q[2 * i + 1] = bfhi(wq[i]); }
            const bf16_t* ksrc = j < 4 ? KN + (size_t)row * 512 + h * 64 + j * 16 : Z0 + (size_t)row * 672 + 640 + (j - 4) * 16;
            const u32x4 c = *(const u32x4*)(ksrc), d = *(const u32x4*)(ksrc + 8);
            const unsigned wk[8] = {c.x, c.y, c.z, c.w, d.x, d.y, d.z, d.w};
#pragma unroll
            for (int i = 0; i < 8; ++i) { k[2 * i] = bflo(wk[i]); k[2 * i + 1] = bfhi(wk[i]); }
#pragma unroll
            for (int i = 0; i < 16; ++i) { sq += q[i] * q[i]; sk += k[i] * k[i]; }
        } else {
#pragma unroll
            for (int i = 0; i < 16; ++i) { q[i] = 0.f; k[i] = 0.f; }
        }
        float tq = 0.f, tk = 0.f;
#pragma unroll
        for (int i = 0; i < 6; ++i) { tq += __shfl(sq, h * 6 + i); tk += __shfl(sk, h * 6 + i); }
        const float rq = rsqrtf(tq * (1.f / 96.f) + EPS), rk = rsqrtf(tk * (1.f / 96.f) + EPS);
        if (act) {
#pragma unroll
            for (int i = 0; i < 16; ++i) { q[i] *= rq * gqn[j * 16 + i]; k[i] *= rk * gkn[j * 16 + i]; }
            if (lat && j >= 4) {
                const int pos = (j == 4) ? prow : pcol;
#pragma unroll
                for (int i = 0; i < 8; ++i) { const float cs = R8[(pos * 8 + i) * 2], sn = R8[(pos * 8 + i) * 2 + 1];
                    const float q1 = q[i], q2 = q[i + 8], k1 = k[i], k2 = k[i + 8];
                    q[i] = q1 * cs - q2 * sn; q[i + 8] = q1 * sn + q2 * cs; k[i] = k1 * cs - k2 * sn; k[i + 8] = k1 * sn + k2 * cs; }
            }
            u32x4 oa, ob, oc, od;
            oa.x = cvtpk(q[0] * qscale, q[1] * qscale); oa.y = cvtpk(q[2] * qscale, q[3] * qscale); oa.z = cvtpk(q[4] * qscale, q[5] * qscale); oa.w = cvtpk(q[6] * qscale, q[7] * qscale);
            ob.x = cvtpk(q[8] * qscale, q[9] * qscale); ob.y = cvtpk(q[10] * qscale, q[11] * qscale); ob.z = cvtpk(q[12] * qscale, q[13] * qscale); ob.w = cvtpk(q[14] * qscale, q[15] * qscale);
            oc.x = cvtpk(k[0], k[1]); oc.y = cvtpk(k[2], k[3]); oc.z = cvtpk(k[4], k[5]); oc.w = cvtpk(k[6], k[7]);
            od.x = cvtpk(k[8], k[9]); od.y = cvtpk(k[10], k[11]); od.z = cvtpk(k[12], k[13]); od.w = cvtpk(k[14], k[15]);
            *(u32x4*)(Q0 + (size_t)row * 768 + h * 96 + j * 16) = oa; *(u32x4*)(Q0 + (size_t)row * 768 + h * 96 + j * 16 + 8) = ob;
            *(u32x4*)(K0 + (size_t)row * 768 + h * 96 + j * 16) = oc; *(u32x4*)(K0 + (size_t)row * 768 + h * 96 + j * 16 + 8) = od;
        }
    }
}
DI void p13_finalize_rows(const KP& P, int gw, int NGW) {
    const int lane = tid_l() & 63;
    bf16_t* QK = (bf16_t*)(P.ws + R1_QK);
    const float* R16 = (const float*)(P.ws + M_ROPE16);
    const int sl = lane & 3;
    const bool isq = lane < 32;
    const float* gain = isq ? P.in[29] : P.in[30];
    const float qscale = 0.125f * LOG2E;
    for (int row = gw; row < T; row += NGW) {
        const bool lat = row < L; const int prow = (row >> 6) & 255, pcol = row & 63;
        bf16_t* p = QK + (size_t)row * 1024 + lane * 16;
        const u32x4 a = *(const u32x4*)p, b = *(const u32x4*)(p + 8);
        const unsigned w[8] = {a.x, a.y, a.z, a.w, b.x, b.y, b.z, b.w};
        float x[16]; float ss = 0.f;
#pragma unroll
        for (int i = 0; i < 8; ++i) { x[2 * i] = bflo(w[i]); x[2 * i + 1] = bfhi(w[i]); }
#pragma unroll
        for (int i = 0; i < 16; ++i) ss += x[i] * x[i];
        ss += __shfl_xor(ss, 1); ss += __shfl_xor(ss, 2);
        const float rstd = rsqrtf(ss * (1.f / 64.f) + EPS);
#pragma unroll
        for (int i = 0; i < 16; ++i) x[i] *= rstd * gain[sl * 16 + i];
        if (lat) {
            const int pos = (sl < 2) ? prow : pcol; const bool first = (sl & 1) == 0;
#pragma unroll
            for (int i = 0; i < 16; ++i) { const float other = __shfl_xor(x[i], 1); const float cs = R16[(pos * 16 + i) * 2], sn = R16[(pos * 16 + i) * 2 + 1];
                x[i] = first ? (x[i] * cs - other * sn) : (other * sn + x[i] * cs); }
        }
        const float s = isq ? qscale : 1.f;
        u32x4 oa, ob;
        oa.x = cvtpk(x[0] * s, x[1] * s); oa.y = cvtpk(x[2] * s, x[3] * s); oa.z = cvtpk(x[4] * s, x[5] * s); oa.w = cvtpk(x[6] * s, x[7] * s);
        ob.x = cvtpk(x[8] * s, x[9] * s); ob.y = cvtpk(x[10] * s, x[11] * s); ob.z = cvtpk(x[12] * s, x[13] * s); ob.w = cvtpk(x[14] * s, x[15] * s);
        *(u32x4*)p = oa; *(u32x4*)(p + 8) = ob;
    }
}

DI void s5_expand(const KP& P, int gtid, int NGT) {
    const float* APOW = (const float*)(P.ws + M_APOW); const float* BB = (const float*)(P.ws + M_BB); const float* KT = (const float*)(P.ws + M_KT);
    const float* Cre = P.in[22]; const float* Cim = P.in[23]; const float* dsk = P.in[24];
    bf16_t* ME = (bf16_t*)(P.ws + R_D); bf16_t* BM = (bf16_t*)(P.ws + R_D2);
    const int NME = 32 * S5N * (S5K / 2);
#pragma unroll 4
    for (int i = gtid; i < NME; i += NGT) {
        const int k2 = i % (S5K / 2), no = (i / (S5K / 2)) % S5N, g = i / ((S5K / 2) * S5N);
        const int t = no >> 4, c = no & 15; float v[2];
#pragma unroll
        for (int e = 0; e < 2; ++e) {
            const int k = k2 * 2 + e; float val = 0.f;
            if (k < 512) { const int s = k >> 4, cp = k & 15;
                if (s <= t) val += KT[((0 * 32 + g) * 32 + (t - s)) * 256 + c * 16 + cp];
                if (s >= t) val += KT[((1 * 32 + g) * 32 + (s - t)) * 256 + c * 16 + cp];
                if (s == t && c == cp) val += dsk[g * 16 + c];
            } else { const int d = (k >= 640) ? 1 : 0, j = k - 512 - 128 * d, n = j & 63, im = j >> 6, pw = d ? (32 - t) : (t + 1), dg = d * 32 + g;
                const float cr = Cre[dg * 1024 + c * 64 + n], ci = Cim[dg * 1024 + c * 64 + n];
                const float pr = APOW[((size_t)dg * 33 + pw) * 128 + n * 2], pi = APOW[((size_t)dg * 33 + pw) * 128 + n * 2 + 1];
                val = im ? -(cr * pi + ci * pr) : (cr * pr - ci * pi); }
            v[e] = val;
        }
        *(unsigned*)(ME + ((size_t)g * S5N + no) * S5K + k2 * 2) = cvtpk(v[0], v[1]);
    }
    const int NBM = 32 * 256 * 256;
#pragma unroll 4
    for (int i = gtid; i < NBM; i += NGT) {
        const int k2 = i & 255, o = (i >> 8) & 255, g = i >> 16; float v[2];
        const int d = o >> 7, n = o & 63, im = (o >> 6) & 1, dg = d * 32 + g;
#pragma unroll
        for (int e = 0; e < 2; ++e) { const int k = k2 * 2 + e, s = k >> 4, cp = k & 15, pw = d ? s : (31 - s);
            const float pr = APOW[((size_t)dg * 33 + pw) * 128 + n * 2], pi = APOW[((size_t)dg * 33 + pw) * 128 + n * 2 + 1];
            const float br = BB[((size_t)dg * 64 + n) * 32 + cp * 2], bi = BB[((size_t)dg * 64 + n) * 32 + cp * 2 + 1];
            v[e] = im ? (pr * bi + pi * br) : (pr * br - pi * bi); }
        *(unsigned*)(BM + ((size_t)g * 256 + o) * 512 + k2 * 2) = cvtpk(v[0], v[1]);
    }
}
DI void s5_chain(const KP& P, int g) {
    const int tid = threadIdx.x;
    if (tid >= 128) return;
    const int d = tid >> 6, n = tid & 63, dg = d * 32 + g;
    const float* APOW = (const float*)(P.ws + M_APOW);
    const float ar = APOW[((size_t)dg * 33 + 32) * 128 + n * 2], ai = APOW[((size_t)dg * 33 + 32) * 128 + n * 2 + 1];
    const float* SS = (const float*)(P.ws + R_E) + (size_t)g * S5M * 256 + d * 128 + n;
    bf16_t* U = (bf16_t*)(P.ws + R_C) + (size_t)g * S5MP * S5K + 512 + d * 128 + n;
    float hr = 0.f, hi_ = 0.f;
    for (int i0 = 0; i0 < S5M; i0 += 40) {
        float sr[40], si[40]; int mm[40];
#pragma unroll
        for (int e = 0; e < 40; ++e) { const int i = i0 + e;
            const int m = d == 0 ? (i < 8 ? 512 + i : i - 8) : (i < 8 ? 519 - i : 519 - i);
            mm[e] = m; sr[e] = SS[(size_t)m * 256]; si[e] = SS[(size_t)m * 256 + 64]; }
#pragma unroll
        for (int e = 0; e < 40; ++e) {
            U[(size_t)mm[e] * S5K] = f2bf(hr); U[(size_t)mm[e] * S5K + 64] = f2bf(hi_);
            const float nr = ar * hr - ai * hi_ + sr[e], ni = ar * hi_ + ai * hr + si[e]; hr = nr; hi_ = ni; }
    }
}

DI bf16x8 frag_plain(const unsigned char* base, int RS, int row0, int k0, int r32, int hi) { return *(const bf16x8*)(base + (row0 + r32) * RS + (k0 + 8 * hi) * 2); }
DI bf16x8 frag_tr(const unsigned char* base, int RS, int k0, int col0, int lane) {
    const int hi = lane >> 5, q = (lane & 15) >> 2, p4 = lane & 3, cb = (lane >> 4) & 1;
    const int addr = (int)(uintptr_t)base + (k0 + 8 * hi + q) * RS + (col0 + 16 * cb + 4 * p4) * 2;
    s16x4 lo, hh;
    asm volatile("ds_read_b64_tr_b16 %0, %1" : "=&v"(lo) : "v"(addr) : "memory");
    asm volatile("ds_read_b64_tr_b16 %0, %1" : "=&v"(hh) : "v"(addr + 4 * RS) : "memory");
    asm volatile("s_waitcnt lgkmcnt(0)" ::: "memory"); __builtin_amdgcn_sched_barrier(0);
    return (bf16x8){lo[0], lo[1], lo[2], lo[3], hh[0], hh[1], hh[2], hh[3]};
}
DI void frag_tr_issue(const unsigned char* base, int RS, int k0, int col0, int lane, s16x4& lo, s16x4& hh) {
    const int hi = lane >> 5, q = (lane & 15) >> 2, p4 = lane & 3, cb = (lane >> 4) & 1;
    const int addr = (int)(uintptr_t)base + (k0 + 8 * hi + q) * RS + (col0 + 16 * cb + 4 * p4) * 2;
    asm volatile("ds_read_b64_tr_b16 %0, %1" : "=&v"(lo) : "v"(addr) : "memory");
    asm volatile("ds_read_b64_tr_b16 %0, %1" : "=&v"(hh) : "v"(addr + 4 * RS) : "memory");
}
#define TRPK(Lq, Hq) (bf16x8){Lq[0], Lq[1], Lq[2], Lq[3], Hq[0], Hq[1], Hq[2], Hq[3]}
constexpr int SA_XS = 0, SA_BS = 18432, SA_CS = 53248, SA_WS = 88064, SA_XW = 122880, SA_FL = 141312;
constexpr int RS64 = 144, RS128 = 272;

template <int NR> DI void conv_strip(const bf16_t* XBC, const float* cw, const float* cbias, int ch, int r0, int s0, int seq_lo, int seq_hi, unsigned char* dst, int rs, int coff) {
    float w[5][8], bias[8];
#pragma unroll
    for (int e = 0; e < 8; ++e) bias[e] = cbias[ch + e];
#pragma unroll
    for (int j = 0; j < 5; ++j)
#pragma unroll
        for (int e = 0; e < 8; ++e) w[j][e] = cw[j * 1024 + ch + e];
    u32x4 raw[NR + 4];
#pragma unroll
    for (int i = 0; i < NR + 4; ++i) { const int row = r0 + s0 + i - 2;
        if (row >= seq_lo && row < seq_hi) raw[i] = *(const u32x4*)(XBC + (size_t)row * 1024 + ch); else raw[i] = (u32x4){0u, 0u, 0u, 0u}; }
#pragma unroll
    for (int o = 0; o < NR; ++o) {
        float a[8];
#pragma unroll
        for (int e = 0; e < 8; ++e) a[e] = bias[e];
#pragma unroll
        for (int j = 0; j < 5; ++j) { const unsigned wv[4] = {raw[o + j].x, raw[o + j].y, raw[o + j].z, raw[o + j].w};
#pragma unroll
            for (int e = 0; e < 4; ++e) { a[2 * e] += w[j][2 * e] * bflo(wv[e]); a[2 * e + 1] += w[j][2 * e + 1] * bfhi(wv[e]); } }
        u32x4 ov; ov.x = cvtpk(silu_f(a[0]), silu_f(a[1])); ov.y = cvtpk(silu_f(a[2]), silu_f(a[3])); ov.z = cvtpk(silu_f(a[4]), silu_f(a[5])); ov.w = cvtpk(silu_f(a[6]), silu_f(a[7]));
        *(u32x4*)(dst + (s0 + o) * rs + coff * 2) = ov;
    }
}
DI void ssd_a_unit(const KP& P, int c, int gi, int hh_lo, int hh_hi, unsigned char* lds) {
    const int tid = tid_l(), lane = tid & 63, wid = tid >> 6, r32 = lane & 31, hi = lane >> 5;
    const int r0 = c * SQ;
    const int seq_lo = c < 128 ? 0 : L, seq_hi = c < 128 ? L : T;
    const bf16_t* XBC = (const bf16_t*)(P.ws + R1_XBC);
    const float* cw = P.in[36]; const float* cbias = P.in[37];
    float* fl = (float*)(lds + SA_FL);
    float* dtf = fl, *dtb = fl + 128, *csf = fl + 256, *ecsb = fl + 384, *wf = fl + 512, *wb = fl + 640;
    { const int oc = tid & 31, strip = tid >> 5;
      const bool isB = oc < 16; const int o16 = oc & 15;
      conv_strip<4>(XBC, cw, cbias, (isB ? 512 : 768) + gi * 128 + o16 * 8, r0, strip * 8, seq_lo, seq_hi, lds + (isB ? SA_BS : SA_CS), RS128, o16 * 8);
      conv_strip<4>(XBC, cw, cbias, (isB ? 512 : 768) + gi * 128 + o16 * 8, r0, strip * 8 + 4, seq_lo, seq_hi, lds + (isB ? SA_BS : SA_CS), RS128, o16 * 8); }
    __syncthreads();
    const int tb = wid >> 1, sh = wid & 1, pb = wid & 1;
    f32x16 G[2];
#pragma unroll
    for (int j = 0; j < 2; ++j)
#pragma unroll
        for (int r = 0; r < 16; ++r) G[j][r] = 0.f;
    const bool need_y = c < 128;
    if (need_y)
#pragma unroll
    for (int kk = 0; kk < 8; ++kk) {
        const bf16x8 a = frag_plain(lds + SA_CS, RS128, tb * 32, kk * 16, r32, hi);
#pragma unroll
        for (int j = 0; j < 2; ++j) { const bf16x8 b = frag_plain(lds + SA_BS, RS128, sh * 64 + j * 32, kk * 16, r32, hi); G[j] = MFMA32(a, b, G[j]); }
    }
    if (hh_lo == 0) { bf16_t* CC = (bf16_t*)(P.ws + R1_CC);
        for (int idx = tid; idx < 128 * 16; idx += NTHREADS) { const int s = idx >> 4, o8 = idx & 15;
            *(u32x4*)(CC + (size_t)(r0 + s) * 256 + gi * 128 + o8 * 8) = *(const u32x4*)(lds + SA_CS + s * RS128 + o8 * 16); } }
    bf16_t* SSg = (bf16_t*)(P.ws + R1_SS);
    const int tid_h = tid;
    __syncthreads();
    constexpr int SA_W2 = SA_CS;
#pragma unroll 1
    for (int hh = hh_lo; hh < hh_hi; ++hh) {
        const int h = gi * 4 + hh;
        int tl = tid_h; asm volatile("" : "+v"(tl));
        const int tid = tl, lane = tl & 63, wid = __builtin_amdgcn_readfirstlane(tl >> 6), r32 = lane & 31, hi = lane >> 5, tb = wid >> 1, sh = wid & 1, pb = wid & 1;
        { const int oc = tl & 7, strip = tl >> 3;
          conv_strip<2>(XBC, cw, cbias, h * 64 + oc * 8, r0, strip * 2, seq_lo, seq_hi, lds + SA_XS, RS64, oc * 8); }
        if (wid < 2) {
            const int d = wid; const float av = -expf(P.in[39][d * 8 + h]), bias = P.in[38][d * 8 + h];
            const float* DTR = (const float*)(P.ws + M_DTR);
            const float t0 = softplus_f(DTR[(size_t)(r0 + 2 * lane) * 16 + d * 8 + h] + bias), t1 = softplus_f(DTR[(size_t)(r0 + 2 * lane + 1) * 16 + d * 8 + h] + bias);
            const float a0 = t0 * av, a1 = t1 * av;
            float inc = a0 + a1;
#pragma unroll
            for (int o = 1; o < 64; o <<= 1) { const float u = __shfl_up(inc, o); if (lane >= o) inc += u; }
            const float excl = inc - (a0 + a1);
            const float tot = __shfl(inc, 63);
            float* CS = (float*)(P.ws + M_CS);
            if (d == 0) { dtf[2 * lane] = t0; dtf[2 * lane + 1] = t1; const float c0 = excl + a0, c1 = excl + a0 + a1; csf[2 * lane] = c0; csf[2 * lane + 1] = c1;
                wf[2 * lane] = t0 * __expf(tot - c0); wf[2 * lane + 1] = t1 * __expf(tot - c1);
                CS[(size_t)(r0 + 2 * lane) * 16 + h] = c0; CS[(size_t)(r0 + 2 * lane + 1) * 16 + h] = c1;
            } else { dtb[2 * lane] = t0; dtb[2 * lane + 1] = t1; const float e0 = excl, e1 = excl + a0; ecsb[2 * lane] = e0; ecsb[2 * lane + 1] = e1;
                wb[2 * lane] = t0 * __expf(e0); wb[2 * lane + 1] = t1 * __expf(e1);
                CS[(size_t)(r0 + 2 * lane) * 16 + 8 + h] = tot - e0; CS[(size_t)(r0 + 2 * lane + 1) * 16 + 8 + h] = tot - e1; }
            if (lane == 0) ((float*)(P.ws + M_DEC))[(d * SNC + c) * 8 + h] = tot;
        }
        __syncthreads();
        if (need_y) {
#pragma unroll
        for (int j = 0; j < 2; ++j) { const int s_ = sh * 64 + j * 32 + r32;
            const float csf_s = csf[s_], ecs_s = ecsb[s_], dtf_s = dtf[s_], dtb_s = dtb[s_];
#pragma unroll
            for (int r = 0; r < 16; ++r) { const int t = tb * 32 + crow(r, hi); const float csf_t = csf[t], ecs_t = ecsb[t];
                const float arg = (s_ <= t) ? (csf_t - csf_s) : (ecs_s - ecs_t);
                const float dts = (s_ < t) ? dtf_s : ((s_ > t) ? dtb_s : dtf_s + dtb_s);
                *(bf16_t*)(lds + SA_WS + t * RS128 + s_ * 2) = f2bf(G[j][r] * __expf(arg) * dts);
                if ((r & 3) == 3) __builtin_amdgcn_sched_barrier(0); } }
        __syncthreads();
        { f32x16 Y;
#pragma unroll
          for (int r = 0; r < 16; ++r) Y[r] = 0.f;
#pragma unroll
          for (int k4 = 0; k4 < 2; ++k4) { s16x4 xl[4], xh[4];
#pragma unroll
              for (int q = 0; q < 4; ++q) frag_tr_issue(lds + SA_XS, RS64, (k4 * 4 + q) * 16, pb * 32, lane, xl[q], xh[q]);
              asm volatile("s_waitcnt lgkmcnt(0)" ::: "memory"); __builtin_amdgcn_sched_barrier(0);
#pragma unroll
              for (int q = 0; q < 4; ++q) { const int kk = k4 * 4 + q; const bf16x8 xb = TRPK(xl[q], xh[q]);
                  const bf16x8 a0 = frag_plain(lds + SA_WS, RS128, tb * 32, kk * 16, r32, hi);
                  Y = MFMA32(a0, xb, Y); } }
          const float dsk = P.in[40][h]; bf16_t* YP = (bf16_t*)(P.ws + R1_YP);
#pragma unroll
          for (int r = 0; r < 16; ++r) { const int t = tb * 32 + crow(r, hi), p = pb * 32 + r32;
              const float xv = bf2f(*(const bf16_t*)(lds + SA_XS + t * RS64 + p * 2));
              YP[(size_t)(r0 + t) * 512 + h * 64 + p] = f2bf(Y[r] + dsk * xv); } }
        __syncthreads();
        }
        for (int idx = tid; idx < 128 * 32; idx += NTHREADS) { const int s_ = idx >> 5, p2 = idx & 31;
            const unsigned v = *(const unsigned*)(lds + SA_XS + s_ * RS64 + p2 * 4); const float w0 = wf[s_], w1 = wb[s_];
            *(unsigned*)(lds + SA_WS + s_ * RS64 + p2 * 4) = cvtpk(bflo(v) * w0, bfhi(v) * w0);
            *(unsigned*)(lds + SA_W2 + s_ * RS64 + p2 * 4) = cvtpk(bflo(v) * w1, bfhi(v) * w1); }
        __syncthreads();
        { const int pbl = wid >> 2, nb = wid & 3;
          f32x16 S0, S1;
#pragma unroll
          for (int r = 0; r < 16; ++r) { S0[r] = 0.f; S1[r] = 0.f; }
#pragma unroll
          for (int k4 = 0; k4 < 4; ++k4) { s16x4 al[2], ah[2], cl[2], ch_[2], bl[2], bh[2];
#pragma unroll
              for (int q = 0; q < 2; ++q) { frag_tr_issue(lds + SA_WS, RS64, (k4 * 2 + q) * 16, pbl * 32, lane, al[q], ah[q]); frag_tr_issue(lds + SA_W2, RS64, (k4 * 2 + q) * 16, pbl * 32, lane, cl[q], ch_[q]);
                  frag_tr_issue(lds + SA_BS, RS128, (k4 * 2 + q) * 16, nb * 32, lane, bl[q], bh[q]); }
              asm volatile("s_waitcnt lgkmcnt(0)" ::: "memory"); __builtin_amdgcn_sched_barrier(0);
#pragma unroll
              for (int q = 0; q < 2; ++q) { const bf16x8 bb = TRPK(bl[q], bh[q]); S0 = MFMA32(TRPK(al[q], ah[q]), bb, S0); S1 = MFMA32(TRPK(cl[q], ch_[q]), bb, S1); } }
          bf16_t* d0p = SSg + ((size_t)(0 * SNC + c) * 8 + h) * 8192; bf16_t* d1p = SSg + ((size_t)(1 * SNC + c) * 8 + h) * 8192;
#pragma unroll
          for (int r = 0; r < 16; ++r) { const int o_ = (pbl * 32 + crow(r, hi)) * 128 + nb * 32 + r32; d0p[o_] = f2bf(S0[r]); d1p[o_] = f2bf(S1[r]); } }
        __syncthreads();
    }
}

DI void ssd_chain(const KP& P, int blk, unsigned char* lds) {
    const int tid = tid_l();
    const int gtid0 = blk * 256, d = gtid0 >> 15, rem0 = gtid0 & 32767, h = rem0 >> 12;
    float* dkl = (float*)(lds + 143360);
    if (tid < SNC) { const int i = tid; const int c = d == 0 ? (i < 2 ? 128 + i : i - 2) : (129 - i);
        dkl[i] = __expf(((const float*)(P.ws + M_DEC))[(d * SNC + c) * 8 + h]); }
    __syncthreads();
    if (tid < 256) {
        unsigned* SSg = (unsigned*)(P.ws + R1_SS) + (size_t)d * SNC * 32768 + rem0 + tid;
        float s0 = 0.f, s1 = 0.f;
#pragma unroll 1
        for (int i0 = 0; i0 < SNC; i0 += 65) {
            unsigned v[65];
#pragma unroll
            for (int e = 0; e < 65; ++e) { const int i = i0 + e; const int c = d == 0 ? (i < 2 ? 128 + i : i - 2) : (129 - i); v[e] = SSg[(size_t)c * 32768]; }
#pragma unroll
            for (int e = 0; e < 65; ++e) { const int i = i0 + e; const int c = d == 0 ? (i < 2 ? 128 + i : i - 2) : (129 - i);
                SSg[(size_t)c * 32768] = cvtpk(s0, s1);
                const float dk = dkl[i]; s0 = dk * s0 + bflo(v[e]); s1 = dk * s1 + bfhi(v[e]); }
        }
    }
    __syncthreads();
}

constexpr int SC_CS = 0, SC_HS = 34816, SC_RED = 104448;
DI void ssd_c_unit(const KP& P, int c, int gi, unsigned char* lds) {
    const int tid = tid_l(), lane = tid & 63, wid = tid >> 6, r32 = lane & 31, hi = lane >> 5;
    const int r0 = c * SQ, tb = wid >> 1, half = wid & 1;
    const bf16_t* CC = (const bf16_t*)(P.ws + R1_CC);
    const bf16_t* SSg = (const bf16_t*)(P.ws + R1_SS);
    const float* CS = (const float*)(P.ws + M_CS);
    for (int idx = tid; idx < 128 * 16; idx += NTHREADS) { const int s = idx >> 4, o8 = idx & 15;
        *(u32x4*)(lds + SC_CS + s * RS128 + o8 * 16) = *(const u32x4*)(CC + (size_t)(r0 + s) * 256 + gi * 128 + o8 * 8); }
    f32x16 tot[4];
#pragma unroll
    for (int j = 0; j < 4; ++j)
#pragma unroll
        for (int r = 0; r < 16; ++r) tot[j][r] = 0.f;
#pragma unroll 1
    for (int d = 0; d < 2; ++d) {
        const bf16_t* src = SSg + ((size_t)(d * SNC + c) * 8 + gi * 4) * 8192;
        for (int idx = tid; idx < 256 * 16; idx += NTHREADS) { const int row = idx >> 4, o8 = idx & 15;
            *(u32x4*)(lds + SC_HS + row * RS128 + o8 * 16) = *(const u32x4*)(src + (size_t)row * 128 + o8 * 8); }
        __syncthreads();
        f32x16 acc[4];
#pragma unroll
        for (int j = 0; j < 4; ++j)
#pragma unroll
            for (int r = 0; r < 16; ++r) acc[j][r] = 0.f;
#pragma unroll
        for (int kk = 0; kk < 8; ++kk) {
            const bf16x8 a = frag_plain(lds + SC_CS, RS128, tb * 32, kk * 16, r32, hi);
#pragma unroll
            for (int j = 0; j < 4; ++j) { const bf16x8 b = frag_plain(lds + SC_HS, RS128, half * 128 + j * 32, kk * 16, r32, hi); acc[j] = MFMA32(a, b, acc[j]); }
        }
#pragma unroll
        for (int r = 0; r < 16; ++r) { const int t = tb * 32 + crow(r, hi);
#pragma unroll
            for (int j = 0; j < 4; ++j) { const int hh = half * 2 + (j >> 1); const float e = __expf(CS[(size_t)(r0 + t) * 16 + d * 8 + gi * 4 + hh]); tot[j][r] += e * acc[j][r]; } }
        __syncthreads();
    }
    const bf16_t* YP = (const bf16_t*)(P.ws + R1_YP); const bf16_t* Z = (const bf16_t*)(P.ws + R1_Z);
    float* red = (float*)(lds + SC_RED);
#pragma unroll
    for (int r = 0; r < 16; ++r) { const int t = tb * 32 + crow(r, hi); float ss = 0.f;
#pragma unroll
        for (int j = 0; j < 4; ++j) { const int colg = half * 128 + j * 32 + r32; const size_t gidx = (size_t)(r0 + t) * 512 + gi * 256 + colg;
            const float y = tot[j][r] + bf2f(YP[gidx]); const float gy = y * silu_f(bf2f(Z[gidx])); tot[j][r] = gy; ss += gy * gy; }
#pragma unroll
        for (int s = 1; s < 32; s <<= 1) ss += __shfl_xor(ss, s);
        if (r32 == 0) red[t * 2 + half] = ss; }
    __syncthreads();
    bf16_t* CAT = (bf16_t*)(P.ws + R_H); const float* gs = P.in[41];
#pragma unroll
    for (int r = 0; r < 16; ++r) { const int t = tb * 32 + crow(r, hi); const float rstd = rsqrtf((red[t * 2] + red[t * 2 + 1]) * (1.f / 256.f) + EPS);
#pragma unroll
        for (int j = 0; j < 4; ++j) { const int colg = half * 128 + j * 32 + r32;
            CAT[(size_t)(r0 + t) * 1024 + 512 + gi * 256 + colg] = f2bf(tot[j][r] * rstd * gs[gi * 256 + colg]); } }
    __syncthreads();
}

namespace pg8 {
#define PG8_LAS __attribute__((address_space(3)))
typedef unsigned short bf16_t;
typedef short bf16x8 __attribute__((ext_vector_type(8)));
typedef float f32x4 __attribute__((ext_vector_type(4)));
typedef unsigned u32x4 __attribute__((ext_vector_type(4)));
constexpr int BM = 256, BK = 64, HALF = 128, HTB = HALF * BK * 2  , STAGE_BYTES = 8 * HTB, NXCD = 8, WGM = 8;

__host__ __device__ __forceinline__ int lds_byte(int r, int c) { const int st = (r >> 4) * 2 + (c >> 5), rr = r & 15, cc = c & 31, ob = rr * 64 + cc * 2; return st * 1024 + (ob ^ (((ob >> 9) & 1) << 5)); }
__host__ __device__ __forceinline__ void stage_rc(int b, int& R, int& C) { const int st = b / 1024, sb = b % 1024, swz = sb ^ (((sb >> 9) & 1) << 5); R = (st >> 1) * 16 + swz / 64; C = (st & 1) * 32 + (swz % 64) / 2; }
__host__ __device__ __forceinline__ int perm32(int rho) { const int n = rho >> 4, i = rho & 15; return 8 * (i >> 2) + 4 * n + (i & 3); }

struct Unit { int pm, pn; };
struct Gemm { const bf16_t* A; const bf16_t* Bt; int M, N, K; int bdiv = 0, nNb = 1; };

struct StaticOrder {
    int nM, nN, nwg, G, c;
    __host__ __device__ void init(int M, int N, int G_, int c_) { nM = M / BM; nN = N / BM; nwg = nM * nN; G = G_; c = c_; }
    __host__ __device__ bool next(int i, Unit& u) const {
        const long L = (long)i * G + c; if (L >= nwg) return false;
        int wgid = (int)L; { const int q = nwg / NXCD, r = nwg % NXCD, xcd = wgid % NXCD, off = wgid / NXCD; wgid = (xcd < r ? xcd * (q + 1) : r * (q + 1) + (xcd - r) * q) + off; }
        const int nig = WGM * nN, gid = wgid / nig, fm = gid * WGM, gsz = (nM - fm) < WGM ? (nM - fm) : WGM;
        u.pm = fm + ((wgid % nig) % gsz); u.pn = (wgid % nig) / gsz; return true;
    }
    __device__ __forceinline__ void a_ready(const Unit&) const {}
    __device__ __forceinline__ void done(const Unit&) const {}
};

typedef unsigned u32x2p __attribute__((ext_vector_type(2)));
__device__ __forceinline__ u32x2p pk4(f32x4 v) { u32x2p w; w.x = ::cvtpk(v[0], v[1]); w.y = ::cvtpk(v[2], v[3]); return w; }
template <int EPI> struct EpiT {
    static constexpr bool PERM = false, AFTER_DRAIN = false;
    const ::KP& P;
    __device__ __forceinline__ void st4(int row, int c, f32x4 v) const {
        unsigned char* ws = P.ws;
        if constexpr (EPI == ::EPI_G1) {
            if (c < 672) *(u32x2p*)((::bf16_t*)(ws + ::R_B) + (size_t)row * 672 + c) = pk4(v);
            else if (c < 1184) { const int cc = c - 672, g = cc >> 4, ch = cc & 15, m_ = row >> 5, s_ = row & 31;
                *(u32x2p*)((::bf16_t*)(ws + ::R_C) + ((size_t)g * ::S5MP + m_) * ::S5K + s_ * 16 + ch) = pk4(v); }
        } else if constexpr (EPI == ::EPI_RES_A0) { const float* mods = (const float*)(ws + ::M_MODS);
            if (row < ::L) { const f32x4 xin = *(const f32x4*)(P.in[0] + (size_t)row * 1024 + c), gg = *(const f32x4*)(mods + 2048 + c); *(f32x4*)(P.out + (size_t)row * 1024 + c) = xin + gg * v; }
            else { const f32x4 xin = *(const f32x4*)(P.in[2] + (size_t)(row - ::L) * 1024 + c), gg = *(const f32x4*)(mods + 6144 + 2048 + c); *(f32x4*)((float*)(ws + ::M_XC) + (size_t)(row - ::L) * 1024 + c) = xin + gg * v; }
        } else if constexpr (EPI == ::EPI_RES_F0) { const float* mods = (const float*)(ws + ::M_MODS);
            if (row < ::L) { f32x4* p = (f32x4*)(P.out + (size_t)row * 1024 + c); const f32x4 gg = *(const f32x4*)(mods + 5120 + c); *p = *p + gg * v; }
            else { f32x4* p = (f32x4*)((float*)(ws + ::M_XC) + (size_t)(row - ::L) * 1024 + c); const f32x4 gg = *(const f32x4*)(mods + 6144 + 5120 + c); *p = *p + gg * v; }
        } else if constexpr (EPI == ::EPI_G8) {
            if (c < 1024) *(u32x2p*)((::bf16_t*)(ws + ::R1_QK) + (size_t)row * 1024 + c) = pk4(v);
            else if (c < 1536) *(u32x2p*)((::bf16_t*)(ws + ::R1_V) + (size_t)row * 512 + c - 1024) = pk4(v);
            else if (c < 2048) *(u32x2p*)((::bf16_t*)(ws + ::R1_Z) + (size_t)row * 512 + c - 1536) = pk4(v);
            else if (c < 3072) *(u32x2p*)((::bf16_t*)(ws + ::R1_XBC) + (size_t)row * 1024 + c - 2048) = pk4(v);
            else if (c < 3088) *(f32x4*)((float*)(ws + ::M_DTR) + (size_t)row * 16 + c - 3072) = v;
        } else if constexpr (EPI == ::EPI_S5S) { const int b_ = row / ::S5MP, m_ = row - b_ * ::S5MP;
            if (m_ < ::S5M) *(f32x4*)((float*)(ws + ::R_E) + ((size_t)b_ * ::S5M + m_) * 256 + c) = v;
        } else if constexpr (EPI == ::EPI_S5Y) { const int b_ = row / ::S5MP, m_ = row - b_ * ::S5MP;
            if (m_ < ::S5M) { const int t_ = c >> 4, ch = c & 15; f32x4 gv; gv[0] = ::gelu_tanh(v[0]); gv[1] = ::gelu_tanh(v[1]); gv[2] = ::gelu_tanh(v[2]); gv[3] = ::gelu_tanh(v[3]);
                *(u32x2p*)((::bf16_t*)((unsigned char*)P.out + ::O_GG) + ((size_t)m_ * 32 + t_) * 512 + b_ * 16 + ch) = pk4(gv); }
        } else if constexpr (EPI == ::EPI_GLU) {
            const u32x2p gw_ = *(const u32x2p*)((const ::bf16_t*)((const unsigned char*)P.out + ::O_GG) + (size_t)row * 512 + c); const f32x4 bb = *(const f32x4*)(P.in[26] + c);
            f32x4 o_; o_[0] = ::bflo(gw_.x) * ::sigmoid_f(v[0] + bb[0]); o_[1] = ::bfhi(gw_.x) * ::sigmoid_f(v[1] + bb[1]); o_[2] = ::bflo(gw_.y) * ::sigmoid_f(v[2] + bb[2]); o_[3] = ::bfhi(gw_.y) * ::sigmoid_f(v[3] + bb[3]);
            *(u32x2p*)((::bf16_t*)(ws + ::R_H) + (size_t)row * 1024 + 512 + c) = pk4(o_);
        } else if constexpr (EPI == ::EPI_RES_A1) { const float* mods = (const float*)(ws + ::M_MODS);
            f32x4* p = (f32x4*)(P.out + (size_t)row * 1024 + c); const f32x4 gg = *(const f32x4*)(mods + 2 * 6144 + 2048 + c); *p = *p + gg * v;
        } else if constexpr (EPI == ::EPI_RES_F1) { const float* mods = (const float*)(ws + ::M_MODS);
            f32x4* p = (f32x4*)(P.out + (size_t)row * 1024 + c); const f32x4 gg = *(const f32x4*)(mods + 2 * 6144 + 5120 + c); *p = *p + gg * v;
        }
    }
    __device__ __forceinline__ void operator()(const f32x4 (&acc)[2][2][4][2], const Unit& u, int wr, int wc, int fr, int fq) const {
        if constexpr (EPI == ::EPI_RES_A0 || EPI == ::EPI_RES_F0 || EPI == ::EPI_RES_A1 || EPI == ::EPI_RES_F1) {
            const float* mods = (const float*)(P.ws + ::M_MODS);
            const bool isctx = (EPI == ::EPI_RES_A0 || EPI == ::EPI_RES_F0) && u.pm * BM >= ::L;
            const int goff = (EPI == ::EPI_RES_A0 ? 2048 : EPI == ::EPI_RES_F0 ? 5120 : EPI == ::EPI_RES_A1 ? 2 * 6144 + 2048 : 2 * 6144 + 5120) + (isctx ? 6144 : 0);
            float* dst = isctx ? (float*)(P.ws + ::M_XC) : P.out;
            const float* src = EPI == ::EPI_RES_A0 ? (isctx ? P.in[2] : P.in[0]) : dst;
            const int rbase = u.pm * BM - (isctx ? ::L : 0) + wr * 64 + fr, cbase = u.pn * BM + wc * 32 + 4 * fq;
#pragma unroll
            for (int ai = 0; ai < 2; ++ai)
#pragma unroll
                for (int bj = 0; bj < 2; ++bj) {
                    f32x4 xin[4][2], gg[2];
#pragma unroll
                    for (int n = 0; n < 2; ++n) gg[n] = *(const f32x4*)(mods + goff + cbase + bj * HALF + n * 16);
#pragma unroll
                    for (int m = 0; m < 4; ++m)
#pragma unroll
                        for (int n = 0; n < 2; ++n) xin[m][n] = *(const f32x4*)(src + (size_t)(rbase + ai * HALF + m * 16) * 1024 + cbase + bj * HALF + n * 16);
#pragma unroll
                    for (int m = 0; m < 4; ++m)
#pragma unroll
                        for (int n = 0; n < 2; ++n) *(f32x4*)(dst + (size_t)(rbase + ai * HALF + m * 16) * 1024 + cbase + bj * HALF + n * 16) = xin[m][n] + gg[n] * acc[ai][bj][m][n];
                }
            return;
        }
#pragma unroll
        for (int ai = 0; ai < 2; ++ai)
#pragma unroll
            for (int m = 0; m < 4; ++m) { const int row = u.pm * BM + ai * HALF + wr * 64 + m * 16 + fr;
#pragma unroll
                for (int n = 0; n < 2; ++n) { const int cl = wc * 32 + n * 16 + 4 * fq, c0 = u.pn * BM + cl;
                    if constexpr (EPI == ::EPI_SWIGLU) { const f32x4 a = acc[ai][0][m][n], b = acc[ai][1][m][n]; f32x4 h;
#pragma unroll
                        for (int e = 0; e < 4; ++e) h[e] = ::silu_f(a[e]) * b[e];
                        *(u32x2p*)((::bf16_t*)(P.ws + ::R_HFF) + (size_t)row * ::DFF + u.pn * HALF + cl) = pk4(h);
                    } else { st4(row, c0, acc[ai][0][m][n]); st4(row, c0 + HALF, acc[ai][1][m][n]); } } }
    }
};

template <class Epi, class Sched, bool ALIGN_EPI = false, bool SP2 = false, int LDA_C = 0>
__device__ __forceinline__ void gemm_phase(PG8_LAS unsigned char* lds, const Gemm g, const Sched& S, const Epi& E) {
    const int tid = threadIdx.x, wid = __builtin_amdgcn_readfirstlane(tid >> 6), lane = tid & 63, wr = wid >> 2, wc = wid & 3, fr = lane & 15, fq = lane >> 4;
    const int K = g.K, nt = K / BK; const int LDA = LDA_C ? LDA_C : g.K;
    unsigned voffA[2], voffB[2];
#pragma unroll
    for (int i = 0; i < 2; ++i) { int R, C; stage_rc(tid * 16 + i * 8192, R, C); const int Rb = Epi::PERM ? ((R & ~31) + perm32(R & 31)) : R;
        voffA[i] = (unsigned)(R * LDA + C) * 2u; voffB[i] = (unsigned)(Rb * K + C) * 2u; }
    const size_t kstep = (size_t)(BK * 2);
    const size_t hstep = (size_t)HALF * K * 2, hstepA = (size_t)HALF * LDA * 2;
    const size_t tstep = 2 * hstep, tstepA = 2 * hstepA;
    const unsigned ldsw = (unsigned)wid * 1024u;
    const int aoff = lds_byte(wr * 64 + fr, fq * 8), boff = lds_byte(wc * 32 + fr, fq * 8);
#define PG8_SA(b, h) (((b) * 2 + (h)) * HTB)
#define PG8_SB(b, h) ((4 + (b) * 2 + (h)) * HTB)
#define PG8_STAGE(bufoff, gbase, voff) do { _Pragma("unroll") for (int _i = 0; _i < 2; ++_i) \
        __builtin_amdgcn_global_load_lds((const unsigned*)((const char*)(gbase) + (voff)[_i]), (PG8_LAS unsigned*)(lds + (bufoff) + ldsw + _i * 8192), 16, 0, 0); } while (0)
#define PG8_LDA(dst, b, h) do { _Pragma("unroll") for (int m = 0; m < 4; ++m) _Pragma("unroll") for (int k = 0; k < 2; ++k) dst[m][k] = *(const PG8_LAS bf16x8*)(lds + PG8_SA(b, h) + aoff + m * 2048 + k * 1024); } while (0)
#define PG8_LDB(dst, b, h) do { _Pragma("unroll") for (int n = 0; n < 2; ++n) _Pragma("unroll") for (int k = 0; k < 2; ++k) dst[n][k] = *(const PG8_LAS bf16x8*)(lds + PG8_SB(b, h) + boff + n * 2048 + k * 1024); } while (0)
#define PG8_MMA(ai, bj, At, Bt) do { __builtin_amdgcn_s_setprio(1); _Pragma("unroll") for (int m = 0; m < 4; ++m) _Pragma("unroll") for (int n = 0; n < 2; ++n) _Pragma("unroll") for (int k = 0; k < 2; ++k) \
        acc[ai][bj][m][n] = __builtin_amdgcn_mfma_f32_16x16x32_bf16(Bt[n][k], At[m][k], acc[ai][bj][m][n], 0, 0, 0); __builtin_amdgcn_s_setprio(0); } while (0)
#define PG8_WAIT_V(n) asm volatile("s_waitcnt vmcnt(" #n ")" ::: "memory")
#define PG8_WAIT_L(n) asm volatile("s_waitcnt lgkmcnt(" #n ")" ::: "memory")
#define PG8_BAR __builtin_amdgcn_s_barrier()
#define PG8_SCHED __builtin_amdgcn_sched_barrier(0)
    Unit cur, nxt; int ui = 0;
    if (!S.next(0, cur)) return;
    f32x4 acc[2][2][4][2];
#pragma unroll
    for (int a = 0; a < 2; ++a)
#pragma unroll
        for (int b = 0; b < 2; ++b)
#pragma unroll
            for (int m = 0; m < 4; ++m)
#pragma unroll
                for (int n = 0; n < 2; ++n) acc[a][b][m][n] = (f32x4){0.f, 0.f, 0.f, 0.f};
    bf16x8 At[4][2], B0[2][2], B1[2][2];
    const char* cA = (const char*)g.A + (size_t)cur.pm * tstepA; const char* cB = (const char*)g.Bt + (size_t)(g.bdiv ? (cur.pm / g.bdiv) * g.nNb + cur.pn : cur.pn) * tstep;
    S.a_ready(cur);
    if constexpr (SP2) {
        PG8_STAGE(PG8_SB(0, 0), cB, voffB); PG8_STAGE(PG8_SB(0, 1), cB + hstep, voffB); PG8_STAGE(PG8_SA(0, 0), cA, voffA); PG8_STAGE(PG8_SA(0, 1), cA + hstepA, voffA);
        if (wr == 1) PG8_BAR;
        PG8_WAIT_V(2); PG8_BAR;
        PG8_STAGE(PG8_SB(1, 0), cB + kstep, voffB); PG8_STAGE(PG8_SA(1, 0), cA + kstep, voffA); PG8_STAGE(PG8_SB(1, 1), cB + hstep + kstep, voffB);
        PG8_WAIT_V(6); PG8_BAR;
    } else {
        PG8_STAGE(PG8_SB(0, 0), cB, voffB); PG8_STAGE(PG8_SA(0, 0), cA, voffA); PG8_STAGE(PG8_SB(0, 1), cB + hstep, voffB); PG8_STAGE(PG8_SA(0, 1), cA + hstepA, voffA);
        if (wr == 1) PG8_BAR;
        PG8_WAIT_V(4); PG8_BAR;
        PG8_STAGE(PG8_SB(1, 0), cB + kstep, voffB); PG8_STAGE(PG8_SA(1, 0), cA + kstep, voffA); PG8_STAGE(PG8_SB(1, 1), cB + hstep + kstep, voffB);
        PG8_WAIT_V(6); PG8_BAR;
    }
    for (;;) {
        const bool has_next = S.next(ui + 1, nxt);
        const char* nA = has_next ? (const char*)g.A + (size_t)nxt.pm * tstepA : cA; const char* nB = has_next ? (const char*)g.Bt + (size_t)(g.bdiv ? (nxt.pm / g.bdiv) * g.nNb + nxt.pn : nxt.pn) * tstep : cB;
#pragma unroll 1
        for (int t = 0; t < nt; t += 2) {
            const bool last = (t == nt - 2);
            const char* a1 = cA + (size_t)(t + 1) * kstep;
            const char* a2 = last ? nA : cA + (size_t)(t + 2) * kstep; const char* b2 = last ? nB : cB + (size_t)(t + 2) * kstep;
            const char* a3 = a2 + kstep; const char* b3 = b2 + kstep;
            if (last && has_next) S.a_ready(nxt);
            if constexpr (SP2) {
            PG8_LDB(B0, 0, 0); PG8_LDB(B1, 0, 1); PG8_SCHED; PG8_LDA(At, 0, 0); PG8_STAGE(PG8_SA(1, 1), a1 + hstepA, voffA);
            PG8_WAIT_V(8); PG8_WAIT_L(0); PG8_BAR; PG8_MMA(0, 0, At, B0); PG8_MMA(0, 1, At, B1); PG8_BAR; PG8_SCHED;
            PG8_LDA(At, 0, 1); PG8_STAGE(PG8_SB(0, 0), b2, voffB); PG8_STAGE(PG8_SB(0, 1), b2 + hstep, voffB); PG8_STAGE(PG8_SA(0, 0), a2, voffA);
            PG8_WAIT_V(8); PG8_WAIT_L(0); PG8_BAR; PG8_MMA(1, 0, At, B0); PG8_MMA(1, 1, At, B1); PG8_BAR; PG8_SCHED;
            PG8_LDB(B0, 1, 0); PG8_LDB(B1, 1, 1); PG8_SCHED; PG8_LDA(At, 1, 0); PG8_STAGE(PG8_SA(0, 1), a2 + hstepA, voffA);
            PG8_WAIT_V(8); PG8_WAIT_L(0); PG8_BAR; PG8_MMA(0, 0, At, B0); PG8_MMA(0, 1, At, B1); PG8_BAR; PG8_SCHED;
            PG8_LDA(At, 1, 1); PG8_STAGE(PG8_SB(1, 0), b3, voffB); PG8_STAGE(PG8_SB(1, 1), b3 + hstep, voffB); PG8_STAGE(PG8_SA(1, 0), a3, voffA);
            PG8_WAIT_V(8); PG8_WAIT_L(0); PG8_BAR; PG8_MMA(1, 0, At, B0); PG8_MMA(1, 1, At, B1); PG8_BAR; PG8_SCHED;
            } else {
            PG8_LDB(B0, 0, 0); PG8_SCHED; PG8_LDA(At, 0, 0); PG8_STAGE(PG8_SA(1, 1), a1 + hstepA, voffA);
            PG8_WAIT_L(8); PG8_BAR; PG8_WAIT_L(0); PG8_MMA(0, 0, At, B0); PG8_BAR; PG8_SCHED;
            PG8_LDB(B1, 0, 1); PG8_STAGE(PG8_SB(0, 0), b2, voffB);
            PG8_BAR; PG8_WAIT_L(0); PG8_MMA(0, 1, At, B1); PG8_BAR;
            PG8_LDA(At, 0, 1); PG8_STAGE(PG8_SA(0, 0), a2, voffA);
            PG8_BAR; PG8_WAIT_L(0); PG8_MMA(1, 0, At, B0); PG8_BAR; PG8_SCHED;
            PG8_STAGE(PG8_SB(0, 1), b2 + hstep, voffB);
            PG8_WAIT_V(6); PG8_BAR; PG8_MMA(1, 1, At, B1); PG8_BAR;
            PG8_LDB(B0, 1, 0); PG8_SCHED; PG8_LDA(At, 1, 0); PG8_STAGE(PG8_SA(0, 1), a2 + hstepA, voffA);
            PG8_WAIT_L(8); PG8_BAR; PG8_WAIT_L(0); PG8_MMA(0, 0, At, B0); PG8_BAR; PG8_SCHED;
            PG8_LDB(B1, 1, 1); PG8_STAGE(PG8_SB(1, 0), b3, voffB);
            PG8_BAR; PG8_WAIT_L(0); PG8_MMA(0, 1, At, B1); PG8_BAR;
            PG8_LDA(At, 1, 1); PG8_STAGE(PG8_SA(1, 0), a3, voffA);
            PG8_BAR; PG8_WAIT_L(0); PG8_MMA(1, 0, At, B0); PG8_BAR; PG8_SCHED;
            PG8_STAGE(PG8_SB(1, 1), b3 + hstep, voffB);
            PG8_WAIT_V(6); PG8_BAR; PG8_MMA(1, 1, At, B1); PG8_BAR;
            }
        }
        if constexpr (ALIGN_EPI) { if (wr == 0) PG8_BAR; }
        if constexpr (!Epi::AFTER_DRAIN) { E(acc, cur, wr, wc, fr, fq); S.done(cur); }
        if (!has_next) break;
#pragma unroll
        for (int a = 0; a < 2; ++a)
#pragma unroll
            for (int b = 0; b < 2; ++b)
#pragma unroll
                for (int m = 0; m < 4; ++m)
#pragma unroll
                    for (int n = 0; n < 2; ++n) acc[a][b][m][n] = (f32x4){0.f, 0.f, 0.f, 0.f};
        cur = nxt; cA = nA; cB = nB; ++ui;
        if constexpr (ALIGN_EPI) { if (wr == 1) PG8_BAR; }
    }
    PG8_WAIT_V(0);
    if constexpr (!ALIGN_EPI) { if (wr == 0) PG8_BAR; }
    PG8_BAR;
    if constexpr (Epi::AFTER_DRAIN) { E.fused(acc, cur, wr, wc, fr, fq, lds, wid, lane); S.done(cur); }
#undef PG8_SA
#undef PG8_SB
#undef PG8_STAGE
#undef PG8_LDA
#undef PG8_LDB
#undef PG8_MMA
#undef PG8_WAIT_V
#undef PG8_WAIT_L
#undef PG8_BAR
#undef PG8_SCHED
}
}

#define XB_TMO      128
#define XB_XCNT(j)  (256  + 64 * (j))
#define XB_XSUB(j)  (1280 + 64 * (j))
#define XB_XGEN(j)  (2304 + 64 * (j))
#define XB_TOP      3328
#define XB_TOPGEN   3392
#define XCD_BAR_WORDS 3456
#define XB_SPIN_CAP (1u << 20)
#define LAS __attribute__((address_space(3)))
DI unsigned xb_ld(unsigned* p)              { return __hip_atomic_load(p, __ATOMIC_RELAXED, __HIP_MEMORY_SCOPE_AGENT); }
DI unsigned xb_add(unsigned* p, unsigned v) { return __hip_atomic_fetch_add(p, v, __ATOMIC_RELAXED, __HIP_MEMORY_SCOPE_AGENT); }
DI unsigned xb_xcc_id() { return (unsigned)__builtin_amdgcn_s_getreg((3 << 11) | 20) & 0xFu; }
#define XB_SPIN(cond, bar) do { unsigned _sp = 0; while (cond) { __builtin_amdgcn_s_sleep(1); \
    if ((++_sp & 255u) == 0u) { if (xb_ld(&(bar)[XB_TMO])) break; if (_sp > XB_SPIN_CAP) { atomicAdd(&(bar)[XB_TMO], 1u); break; } } } } while (0)
struct XcdBarrier { unsigned* bar; unsigned x; volatile LAS unsigned* st; };
DI XcdBarrier xcd_barrier_post(unsigned* bar, volatile LAS unsigned* st) {
    XcdBarrier b; b.bar = bar; b.x = xb_xcc_id(); b.st = st;
    if (threadIdx.x == 0) (void)xb_add(&bar[XB_XCNT(b.x)], 1u);
    return b;
}
DI void xcd_barrier_complete(unsigned* bar, unsigned x, unsigned& nloc, unsigned& nx) {
    const unsigned G = gridDim.x * gridDim.y * gridDim.z;
    unsigned sum, cnt, mine, sp = 0u;
    for (;;) {
        sum = 0u; cnt = 0u; mine = 0u;
#pragma unroll
        for (unsigned j = 0; j < 16; ++j) { const unsigned c = xb_ld(&bar[XB_XCNT(j)]); sum += c; cnt += (c > 0u) ? 1u : 0u; mine = (j == x) ? c : mine; }
        if (sum == G) break;
        __builtin_amdgcn_s_sleep(1);
        if ((++sp & 255u) == 0u) { if (xb_ld(&bar[XB_TMO])) break; if (sp > XB_SPIN_CAP) { atomicAdd(&bar[XB_TMO], 1u); break; } }
    }
    nloc = mine > 0u ? mine : 1u; nx = cnt > 0u ? cnt : 1u;
}
DI void xcd_barrier(const XcdBarrier& b) {
    asm volatile("s_waitcnt vmcnt(0)" ::: "memory");
    __syncthreads();
    if (threadIdx.x == 0) {
        unsigned* bar = b.bar;
        __builtin_amdgcn_s_waitcnt(0);
        unsigned nloc = b.st[0], nx = b.st[1];
        if (nloc == 0u) { xcd_barrier_complete(bar, b.x, nloc, nx); b.st[0] = nloc; b.st[1] = nx; }
        const unsigned old = xb_add(&bar[XB_XSUB(b.x)], 1u);
        const unsigned gen = old / nloc;
        if (old + 1u == (gen + 1u) * nloc) {
            __builtin_amdgcn_fence(__ATOMIC_RELEASE, "agent");
            asm volatile("s_waitcnt vmcnt(0)" ::: "memory");
            const unsigned og = xb_add(&bar[XB_TOP], 1u);
            const unsigned tg = og / nx;
            if (og + 1u == (tg + 1u) * nx) xb_add(&bar[XB_TOPGEN], 1u);
            else XB_SPIN(xb_ld(&bar[XB_TOPGEN]) == tg, bar);
            __builtin_amdgcn_fence(__ATOMIC_ACQUIRE, "agent");
            xb_add(&bar[XB_XGEN(b.x)], 1u);
            asm volatile("s_waitcnt vmcnt(0)" ::: "memory");
        } else {
            XB_SPIN(xb_ld(&bar[XB_XGEN(b.x)]) == gen, bar);
            __builtin_amdgcn_fence(__ATOMIC_ACQUIRE, "agent");
            asm volatile("s_waitcnt vmcnt(0)" ::: "memory");
        }
    }
    __syncthreads();
}

DI void split_arrive(unsigned* bar, int word) {
    asm volatile("s_waitcnt vmcnt(0)" ::: "memory");
    __syncthreads();
    if (threadIdx.x == 0) { __builtin_amdgcn_fence(__ATOMIC_RELEASE, "agent"); asm volatile("s_waitcnt vmcnt(0)" ::: "memory"); (void)xb_add(&bar[word], 1u); }
}
DI void split_wait(unsigned* bar, int word, unsigned target) {
    if (threadIdx.x == 0) { XB_SPIN(xb_ld(&bar[word]) < target, bar); __builtin_amdgcn_fence(__ATOMIC_ACQUIRE, "agent"); asm volatile("s_waitcnt vmcnt(0)" ::: "memory"); }
    __syncthreads();
}

constexpr int NPHASES = 20;
__global__ void __launch_bounds__(NTHREADS, 2) hybrid_fwd(KP P) {
    extern __shared__ __attribute__((aligned(16))) unsigned char lds[];
    const int bid = blockIdx.x, G = gridDim.x;
    const int NGW = G * NWAVES, NGT = G * NTHREADS;
#define gw (bid * NWAVES + (tid_l() >> 6))
#define gtid (bid * NTHREADS + tid_l())
    unsigned char* ws = P.ws;
    const int lo = P.ph_lo, hi = P.ph_hi;
#ifndef REPEAT_MASK
#define REPEAT_MASK 0
#endif
#define REP(k) for (int rep_ = 0; rep_ <= ((REPEAT_MASK >> (k)) & 1); ++rep_)
#ifdef ONLY_PHASES
#define IN(k) (((ONLY_PHASES >> (k)) & 1) && lo <= (k) && (k) < hi)
#else
#define IN(k) (lo <= (k) && (k) < hi)
#endif
    volatile LAS unsigned* bst = (volatile LAS unsigned*)(LAS unsigned char*)(lds + LDS_BYTES - 16);
    if (threadIdx.x == 0) { bst[0] = 0u; bst[1] = 0u; }
    __syncthreads();
    XcdBarrier xbar; xbar.bar = (unsigned*)(P.ws + M_BAR); xbar.x = 0; xbar.st = bst;
    if (hi - lo > 1) xbar = xcd_barrier_post((unsigned*)(P.ws + M_BAR), bst);
    if (lo == 0x7fffffff) cg::this_grid().sync();
#define SYNC_AFTER(k) do { if (IN(k) && IN((k) + 1)) { xcd_barrier(xbar); } } while (0)
    const bf16_t* Hb = (const bf16_t*)(ws + R_A);
    const bf16_t* CATb = (const bf16_t*)(ws + R_H);
    const bf16_t* HFFb = (const bf16_t*)(ws + R_HFF);

    if (IN(0)) REP(0) {
        for (int it = bid; it < 256; it += G) { if (it < 192) p0_ada_item(P, it, lds); else p0_s5_tables(P, it - 192, lds); }
        if (bid == 0) p0_consts(P);
        if (rep_ == 0) split_arrive((unsigned*)(ws + M_BAR), 42);
        p0_weights(P, lds, gw, NGW, 0);
        __syncthreads();
    }
    if (IN(1)) REP(1) {
        if (rep_ == 0) split_wait((unsigned*)(ws + M_BAR), 42, (unsigned)G);
        modulate_rows(P, P.in[0], P.in[2], 0, 0, T, gw, NGW);
        for (int i = gtid; i < NC * 1024 / 4; i += NGT) ((f32x4*)(ws + M_XC))[i] = ((const f32x4*)P.in[2])[i];
        s5_expand(P, gtid, NGT);
    }
    SYNC_AFTER(1);
    if (IN(2)) REP(2) {
        { pg8::Gemm g{Hb, (const bf16_t*)(ws + W_IN0), T, 1280, 1024}; pg8::StaticOrder S; S.init(T, 1280, G, bid);
          pg8::EpiT<EPI_G1> E{P}; pg8::gemm_phase<pg8::EpiT<EPI_G1>, pg8::StaticOrder, true, true>((PG8_LAS unsigned char*)lds, g, S, E); }
    }
    SYNC_AFTER(2);
    if (IN(3)) REP(3) {
        { pg8::Gemm g{(const bf16_t*)(ws + R_C), (const bf16_t*)(ws + R_D2), 32 * S5MP, 256, 512, 3, 1}; pg8::StaticOrder S; S.init(32 * S5MP, 256, G, bid);
          pg8::EpiT<EPI_S5S> E{P}; pg8::gemm_phase<pg8::EpiT<EPI_S5S>, pg8::StaticOrder, true, true, S5K>((PG8_LAS unsigned char*)lds, g, S, E); }
        if (rep_ == 0) p3_norm_rows(P, gw, NGW);
    }
    SYNC_AFTER(3);
    if (IN(4)) REP(4) {
        if (bid < 32) s5_chain(P, bid);
        __syncthreads();
        const GP g1{(const bf16_t*)(ws + R_B), (const bf16_t*)(ws + W_QB), 0, 0, 672, 384, 384, T, 65, 3, 1, EPI_QRAW};
        const int vbid = (bid + 455 % G) % G;
        gemm_phase<EPI_QRAW>(P, g1, lds, vbid, G, 0);
        const GP g2{(const bf16_t*)(ws + R_B) + 384, (const bf16_t*)(ws + W_KVB), 0, 0, 672, 256, 256, T, 65, 4, 1, EPI_KV};
        gemm_phase<EPI_KV>(P, g2, lds, vbid, G, 195);
    }
    SYNC_AFTER(4);
    if (IN(5)) REP(5) {
        { pg8::Gemm g{(const bf16_t*)(ws + R_C), (const bf16_t*)(ws + R_D), 32 * S5MP, 512, 768, 3, 2}; pg8::StaticOrder S; S.init(32 * S5MP, 512, G, bid);
          pg8::EpiT<EPI_S5Y> E{P}; pg8::gemm_phase<pg8::EpiT<EPI_S5Y>, pg8::StaticOrder, true, true>((PG8_LAS unsigned char*)lds, g, S, E); }
        if (rep_ == 0) p5_finalize_rows(P, gw, NGW);
    }
    SYNC_AFTER(5);
    if (IN(6)) REP(6) {
        for (int u = bid; u < 520; u += G) { if (u < 512) mla_attn_unit(P, u >> 3, u & 7, lds); else mla_attn_unit(P, 64, u - 512, lds); }
        { pg8::Gemm g{(const bf16_t*)((const unsigned char*)P.out + O_GG), (const bf16_t*)(ws + W_GLU), T, 512, 512}; pg8::StaticOrder S; S.init(T, 512, G, (bid + G - 8) % G);
          pg8::EpiT<EPI_GLU> E{P}; pg8::gemm_phase<pg8::EpiT<EPI_GLU>, pg8::StaticOrder, true, true>((PG8_LAS unsigned char*)lds, g, S, E); }
    }
    SYNC_AFTER(6);
    if (IN(7)) REP(7) {
        { pg8::Gemm g{CATb, (const bf16_t*)(ws + W_OUT0), L, 1024, 1024}; pg8::StaticOrder S; S.init(L, 1024, G, bid);
          pg8::EpiT<EPI_RES_A0> E{P}; pg8::gemm_phase<pg8::EpiT<EPI_RES_A0>, pg8::StaticOrder, true, true>((PG8_LAS unsigned char*)lds, g, S, E); }
        if (rep_ == 0) {
            const GP gc{CATb + (size_t)L * 1024, (const bf16_t*)(ws + W_OUT0), 128, 128, 1024, 1024, 128, NC, 1, 4, 8, EPI_CTX_A0};
            gemm_phase<EPI_CTX_A0>(P, gc, lds, bid, G, 64); }
    }
    SYNC_AFTER(7);
    if (IN(8)) REP(8) modulate_rows(P, P.out, (const float*)(ws + M_XC), 0, 3, T, gw, NGW);
    SYNC_AFTER(8);
    if (IN(9)) REP(9) {
        { pg8::Gemm g{Hb, (const bf16_t*)(ws + W_13_0), T, 5632, 1024}; pg8::StaticOrder S; S.init(T, 5632, G, bid);
          pg8::EpiT<EPI_SWIGLU> E{P}; pg8::gemm_phase<pg8::EpiT<EPI_SWIGLU>, pg8::StaticOrder, true, true>((PG8_LAS unsigned char*)lds, g, S, E); }
    }
    SYNC_AFTER(9);
    if (IN(10)) REP(10) {
        { pg8::Gemm g{HFFb, (const bf16_t*)(ws + W_2_0), L, 1024, 2816}; pg8::StaticOrder S; S.init(L, 1024, G, bid);
          pg8::EpiT<EPI_RES_F0> E{P}; pg8::gemm_phase<pg8::EpiT<EPI_RES_F0>, pg8::StaticOrder, true, true>((PG8_LAS unsigned char*)lds, g, S, E); }
        {
            const GP gc{HFFb + (size_t)L * 2816, (const bf16_t*)(ws + W_2_0), 256, 256, 2816, 2816, 256, NC, 1, 4, 11, EPI_CTX_F0};
            gemm_phase<EPI_CTX_F0>(P, gc, lds, bid, G, 64); }
    }
    SYNC_AFTER(10);
    if (IN(11)) REP(11) modulate_rows(P, P.out, (const float*)(ws + M_XC), 1, 0, T, gw, NGW);
    SYNC_AFTER(11);
    if (IN(12)) REP(12) {
        { pg8::Gemm g{Hb, (const bf16_t*)(ws + W_IN1), T, 3328, 1024}; pg8::StaticOrder S; S.init(T, 3328, G, bid);
          pg8::EpiT<EPI_G8> E{P}; pg8::gemm_phase<pg8::EpiT<EPI_G8>, pg8::StaticOrder, true, true>((PG8_LAS unsigned char*)lds, g, S, E); }
        if (rep_ == 0) { const int nu = 65 * 13, rem = nu % G;
            if (rem != 0 && G - rem >= 64) { if (bid >= rem) p0_weights(P, lds, (bid - rem) * NWAVES + (tid_l() >> 6), (G - rem) * NWAVES, 1); }
            else p0_weights(P, lds, gw, NGW, 1);
            __syncthreads(); }
    }
    SYNC_AFTER(12);
    if (IN(13)) REP(13) {
        if (rep_ == 0) { if (G > 64) { if (bid >= 16) p13_finalize_rows(P, gw - 16 * NWAVES, NGW - 16 * NWAVES); } else p13_finalize_rows(P, gw, NGW); }
        for (int u = bid; u < 256 + 16; u += G) {
            if (u < 256) ssd_a_unit(P, u >> 1, u & 1, 0, 4, lds);
            else { const int v = u - 256, c = 128 + (v >> 3), h = v & 7; ssd_a_unit(P, c, h >> 2, h & 3, (h & 3) + 1, lds); }
        }
    }
    SYNC_AFTER(13);
    if (IN(14)) REP(14) {
        if (rep_ == 0) for (int q = bid; q < 256; q += G) ssd_chain(P, q, lds);
        for (int u = bid; u < 256; u += G) diff_attn_unit(P, u >> 2, u & 3, lds);
    }
    SYNC_AFTER(14);
    if (IN(15)) REP(15) { for (int u = bid; u < 256; u += G) ssd_c_unit(P, u >> 1, u & 1, lds); }
    SYNC_AFTER(15);
    if (IN(16)) REP(16) {
        { pg8::Gemm g{CATb, (const bf16_t*)(ws + W_OUT1), L, 1024, 1024}; pg8::StaticOrder S; S.init(L, 1024, G, bid);
          pg8::EpiT<EPI_RES_A1> E{P}; pg8::gemm_phase<pg8::EpiT<EPI_RES_A1>, pg8::StaticOrder, true, true>((PG8_LAS unsigned char*)lds, g, S, E); }
    }
    SYNC_AFTER(16);
    if (IN(17)) REP(17) modulate_rows(P, P.out, (const float*)(ws + M_XC), 1, 3, L, gw, NGW);
    SYNC_AFTER(17);
    if (IN(18)) REP(18) {
        { pg8::Gemm g{Hb, (const bf16_t*)(ws + W_13_1), L, 5632, 1024}; pg8::StaticOrder S; S.init(L, 5632, G, bid);
          pg8::EpiT<EPI_SWIGLU> E{P}; pg8::gemm_phase<pg8::EpiT<EPI_SWIGLU>, pg8::StaticOrder, true, true>((PG8_LAS unsigned char*)lds, g, S, E); }
    }
    SYNC_AFTER(18);
    if (IN(19)) REP(19) {
        { pg8::Gemm g{HFFb, (const bf16_t*)(ws + W_2_1), L, 1024, 2816}; pg8::StaticOrder S; S.init(L, 1024, G, bid);
          pg8::EpiT<EPI_RES_F1> E{P}; pg8::gemm_phase<pg8::EpiT<EPI_RES_F1>, pg8::StaticOrder, true, true>((PG8_LAS unsigned char*)lds, g, S, E); }
    }
#undef IN
#undef SYNC_AFTER
#undef gw
#undef gtid
}

extern "C" void kernel_launch(void* const* d_in, const int* in_sizes, int n_in, void* d_out, int out_size, void* d_ws, size_t ws_size, hipStream_t stream) {
    static int grid = 0;
    if (grid == 0) {
        if (n_in != 42 || out_size != L * DM || ws_size < WS_NEED) { fprintf(stderr, "kernel_launch: unexpected shapes n_in %d out %d ws %zu (need %zu)\n", n_in, out_size, ws_size, (size_t)WS_NEED); grid = -1; return; }
        int dev = 0, cus = 0, per_cu = 0;
        (void)hipGetDevice(&dev); (void)hipDeviceGetAttribute(&cus, hipDeviceAttributeMultiprocessorCount, dev);
        if (hipFuncSetAttribute((const void*)hybrid_fwd, hipFuncAttributeMaxDynamicSharedMemorySize, LDS_BYTES) != hipSuccess) { fprintf(stderr, "kernel_launch: hipFuncSetAttribute failed\n"); grid = -1; return; }
        if (hipOccupancyMaxActiveBlocksPerMultiprocessor(&per_cu, (const void*)hybrid_fwd, NTHREADS, LDS_BYTES) != hipSuccess || per_cu < 1) { fprintf(stderr, "kernel_launch: occupancy query failed (%d)\n", per_cu); per_cu = 1; }
        (void)hipGetLastError();
        grid = cus;
        fprintf(stderr, "kernel_launch: cus %d per_cu %d grid %d ws %zu need %zu\n", cus, per_cu, grid, ws_size, (size_t)WS_NEED);
    }
    if (grid < 0) return;
    KP p{};
    for (int i = 0; i < 42; ++i) p.in[i] = (const float*)d_in[i];
    p.out = (float*)d_out; p.ws = (unsigned char*)d_ws;
#if N_LAUNCH_MODE == 1
    for (int ph = 0; ph < NPHASES; ++ph) { p.ph_lo = ph; p.ph_hi = ph + 1; hipLaunchKernelGGL(hybrid_fwd, dim3(grid), dim3(NTHREADS), LDS_BYTES, stream, p); }
#else
    p.ph_lo = 0; p.ph_hi = NPHASES;
    if (hipMemsetAsync((unsigned char*)d_ws + M_BAR, 0, XCD_BAR_WORDS * 4, stream) != hipSuccess) { fprintf(stderr, "kernel_launch: memset failed\n"); return; }
    void* args[] = {&p};
    hipError_t e = hipLaunchCooperativeKernel((const void*)hybrid_fwd, dim3(grid), dim3(NTHREADS), args, LDS_BYTES, stream);
    if (e != hipSuccess) fprintf(stderr, "kernel_launch: cooperative launch failed: %s (grid %d)\n", hipGetErrorString(e), grid);
#endif
}
```
